# Optimizing an MI355X kernel written in HIP

```python
import jax, jax.numpy as jnp
from jax import lax
import numpy as np

D_MODEL = 1024
BATCH = 4
SEQ = 8192
DEPTH = 1

N_MEM = 256
MLA_HEADS = 8
MLA_Q_RANK = 256
MLA_KV_RANK = 128
MLA_NOPE_DIM = 64
MLA_ROPE_DIM = 32
MLA_V_DIM = 64
MLA_QK_DIM = MLA_NOPE_DIM + MLA_ROPE_DIM
DSA_HEADS = 8
DSA_KV_HEADS = 2
DSA_HEAD_DIM = 64
IDX_HEADS = 8
IDX_DIM = 64
PARTIAL_ROT_DIM = DSA_HEAD_DIM // 4
INDEX_TOPK_MAX = 256
MEM_HEADS = 4
MEM_HEAD_DIM = 128
D_FF = ((8 * D_MODEL // 3 + 255) // 256) * 256
ROPE_THETA = 500000.0
EPS = 1e-6
QBLOCK = 128
MIX_WIDTH = MLA_HEADS * MLA_V_DIM + DSA_HEADS * DSA_HEAD_DIM
IN_SPLIT_SIZES = (MLA_Q_RANK, MLA_KV_RANK, MLA_ROPE_DIM,
                  DSA_HEADS * DSA_HEAD_DIM, DSA_KV_HEADS * DSA_HEAD_DIM, DSA_KV_HEADS * DSA_HEAD_DIM,
                  IDX_HEADS * IDX_DIM, IDX_DIM, IDX_HEADS)
IN_COLS = sum(IN_SPLIT_SIZES)

kernel_name = 'hybrid_mla_dsa_parallel_heads'


def rmsnorm(x, g):
    x32 = x.astype(jnp.float32)
    y = x32 * lax.rsqrt(jnp.mean(x32 * x32, axis=-1, keepdims=True) + EPS)
    return (y * g.astype(jnp.float32)).astype(x.dtype)


def rope_tables(positions, rot_dim):
    inv_freq = ROPE_THETA ** (-jnp.arange(0, rot_dim, 2, dtype=jnp.float32) / rot_dim)
    ang = positions.astype(jnp.float32)[..., None] * inv_freq
    return jnp.cos(ang)[:, :, None, :], jnp.sin(ang)[:, :, None, :]


def rotate(x, cos, sin):
    x1, x2 = jnp.split(x.astype(jnp.float32), 2, axis=-1)
    return jnp.concatenate([x1 * cos - x2 * sin, x2 * cos + x1 * sin], axis=-1).astype(x.dtype)


def partial_rope(x, cos, sin, rot_dim):
    return jnp.concatenate([rotate(x[..., :rot_dim], cos, sin), x[..., rot_dim:]], axis=-1)


def to_blocks(a, nb):
    return a.reshape((a.shape[0], nb, QBLOCK) + a.shape[2:]).swapaxes(0, 1)


def causal_block_attention(q, k, v, scale):
    B, S, H, _ = q.shape
    nb = S // QBLOCK
    k32 = k.astype(jnp.float32)
    key_pos = jnp.arange(S)

    def one_block(args):
        q_blk, start = args
        q_pos = start + jnp.arange(QBLOCK)
        s = jnp.einsum('bqhd,bshd->bhqs', q_blk.astype(jnp.float32), k32) * scale
        s = jnp.where((key_pos[None, :] <= q_pos[:, None])[None, None], s, -jnp.inf)
        p = jax.nn.softmax(s, axis=-1)
        return jnp.einsum('bhqs,bshd->bqhd', p.astype(v.dtype), v)

    out = lax.map(one_block, (to_blocks(q, nb), jnp.arange(nb) * QBLOCK))
    return out.swapaxes(0, 1).reshape(B, S, H, v.shape[-1])


def dsa_sparse_attention(q, k, v, q_idx, k_idx, w_idx, scale, top_k):
    B, S, H, d = q.shape
    G = k.shape[2]
    R = H // G
    nb = S // QBLOCK
    k_idx32 = k_idx.astype(jnp.float32)
    key_pos = jnp.arange(S)
    gather = jax.vmap(lambda table, idx: table[idx])

    def one_block(args):
        q_blk, qi_blk, wi_blk, start = args
        q_pos = start + jnp.arange(QBLOCK)
        rel = jax.nn.relu(jnp.einsum('bqhd,bsd->bqhs', qi_blk.astype(jnp.float32), k_idx32) * IDX_DIM ** -0.5)
        score = jnp.einsum('bqhs,bqh->bqs', rel, wi_blk.astype(jnp.float32))
        score = jnp.where((key_pos[None, :] <= q_pos[:, None])[None], score, -jnp.inf)
        _, sel = lax.top_k(score, top_k)
        valid = sel <= q_pos[None, :, None]
        k_sel = gather(k, sel)
        v_sel = gather(v, sel)
        qg = q_blk.reshape(B, QBLOCK, G, R, d)
        s = jnp.einsum('bqgrd,bqkgd->bqgrk', qg.astype(jnp.float32), k_sel.astype(jnp.float32)) * scale
        s = jnp.where(valid[:, :, None, None, :], s, -jnp.inf)
        p = jax.nn.softmax(s, axis=-1)
        o = jnp.einsum('bqgrk,bqkgd->bqgrd', p.astype(v.dtype), v_sel)
        return o.reshape(B, QBLOCK, H, d)

    out = lax.map(one_block, (to_blocks(q, nb), to_blocks(q_idx, nb), to_blocks(w_idx, nb),
                              jnp.arange(nb) * QBLOCK))
    return out.swapaxes(0, 1).reshape(B, S, H, d)


def hybrid_mixer(h, cos_m, sin_m, cos_p, sin_p, top_k, w_in, mla_q_a_norm, mla_w_uq, mla_kv_a_norm,
                 mla_w_ukv, mla_q_norm, mla_k_norm, dsa_q_norm, dsa_k_norm, idx_k_norm, w_out):
    B, S, _ = h.shape
    offsets = np.cumsum(IN_SPLIT_SIZES)[:-1].tolist()
    c_q, c_kv, k_pe, q_d, k_d, v_d, q_i, k_i, w_i = jnp.split(h @ w_in, offsets, axis=-1)

    q_m = (rmsnorm(c_q, mla_q_a_norm) @ mla_w_uq).reshape(B, S, MLA_HEADS, MLA_QK_DIM)
    kv_m = (rmsnorm(c_kv, mla_kv_a_norm) @ mla_w_ukv).reshape(B, S, MLA_HEADS, MLA_NOPE_DIM + MLA_V_DIM)
    k_nope, v_m = kv_m[..., :MLA_NOPE_DIM], kv_m[..., MLA_NOPE_DIM:]
    k_m = jnp.concatenate([k_nope, jnp.broadcast_to(k_pe[:, :, None, :], (B, S, MLA_HEADS, MLA_ROPE_DIM))], axis=-1)
    q_m = rmsnorm(q_m, mla_q_norm)
    k_m = rmsnorm(k_m, mla_k_norm)
    q_m = jnp.concatenate([q_m[..., :MLA_NOPE_DIM], rotate(q_m[..., MLA_NOPE_DIM:], cos_m, sin_m)], axis=-1)
    k_m = jnp.concatenate([k_m[..., :MLA_NOPE_DIM], rotate(k_m[..., MLA_NOPE_DIM:], cos_m, sin_m)], axis=-1)
    o_mla = causal_block_attention(q_m, k_m, v_m, MLA_QK_DIM ** -0.5)

    q_d = partial_rope(rmsnorm(q_d.reshape(B, S, DSA_HEADS, DSA_HEAD_DIM), dsa_q_norm), cos_p, sin_p, PARTIAL_ROT_DIM)
    k_d = partial_rope(rmsnorm(k_d.reshape(B, S, DSA_KV_HEADS, DSA_HEAD_DIM), dsa_k_norm), cos_p, sin_p, PARTIAL_ROT_DIM)
    v_d = v_d.reshape(B, S, DSA_KV_HEADS, DSA_HEAD_DIM)
    q_i = partial_rope(q_i.reshape(B, S, IDX_HEADS, IDX_DIM), cos_p, sin_p, PARTIAL_ROT_DIM)
    k_i = partial_rope(rmsnorm(k_i, idx_k_norm)[:, :, None, :], cos_p, sin_p, PARTIAL_ROT_DIM)[:, :, 0, :]
    o_dsa = dsa_sparse_attention(q_d, k_d, v_d, q_i, k_i, w_i * IDX_HEADS ** -0.5, DSA_HEAD_DIM ** -0.5, top_k)

    mixed = jnp.concatenate([o_mla.reshape(B, S, -1), o_dsa.reshape(B, S, -1)], axis=-1)
    return mixed @ w_out


def memory_cross_attention(h, mem_n, w_q, w_k, w_v, q_norm, k_norm, w_o):
    B, S, _ = h.shape
    N = mem_n.shape[1]
    q = rmsnorm((h @ w_q).reshape(B, S, MEM_HEADS, MEM_HEAD_DIM), q_norm)
    k = rmsnorm((mem_n @ w_k).reshape(B, N, MEM_HEADS, MEM_HEAD_DIM), k_norm)
    v = (mem_n @ w_v).reshape(B, N, MEM_HEADS, MEM_HEAD_DIM)
    s = jnp.einsum('bshd,bnhd->bhsn', q.astype(jnp.float32), k.astype(jnp.float32)) * MEM_HEAD_DIM ** -0.5
    p = jax.nn.softmax(s, axis=-1)
    o = jnp.einsum('bhsn,bnhd->bshd', p.astype(v.dtype), v)
    return o.reshape(B, S, MEM_HEADS * MEM_HEAD_DIM) @ w_o


def swiglu_ffn(h, w_gate, w_up, w_down):
    return (jax.nn.silu(h @ w_gate) * (h @ w_up)) @ w_down


def setup_inputs(seed: int = 0) -> dict:
    key = jax.random.key(seed)
    ks = jax.random.split(key, 32)
    f32 = jnp.float32

    def w(k, shape, fan_in):
        return jax.random.normal(k, (DEPTH,) + shape, f32) * fan_in ** -0.5

    def g(k, n):
        return 1.0 + 0.1 * jax.random.normal(k, (DEPTH, n), f32)

    mem_w = MEM_HEADS * MEM_HEAD_DIM
    return {
        'x': jax.random.normal(ks[0], (BATCH, SEQ, D_MODEL), f32),
        'mem': jax.random.normal(ks[1], (BATCH, N_MEM, D_MODEL), f32),
        'positions': (jax.random.randint(ks[2], (BATCH, 1), 0, 1024) + jnp.arange(SEQ)[None, :]).astype(jnp.int32),
        'norm_mix': g(ks[3], D_MODEL),
        'w_in': w(ks[4], (D_MODEL, IN_COLS), D_MODEL),
        'mla_q_a_norm': g(ks[5], MLA_Q_RANK),
        'mla_w_uq': w(ks[6], (MLA_Q_RANK, MLA_HEADS * MLA_QK_DIM), MLA_Q_RANK),
        'mla_kv_a_norm': g(ks[7], MLA_KV_RANK),
        'mla_w_ukv': w(ks[8], (MLA_KV_RANK, MLA_HEADS * (MLA_NOPE_DIM + MLA_V_DIM)), MLA_KV_RANK),
        'mla_q_norm': g(ks[9], MLA_QK_DIM),
        'mla_k_norm': g(ks[10], MLA_QK_DIM),
        'dsa_q_norm': g(ks[11], DSA_HEAD_DIM),
        'dsa_k_norm': g(ks[12], DSA_HEAD_DIM),
        'idx_k_norm': g(ks[13], IDX_DIM),
        'w_out': w(ks[14], (MIX_WIDTH, D_MODEL), MIX_WIDTH),
        'norm_mem_x': g(ks[15], D_MODEL),
        'norm_mem_kv': g(ks[16], D_MODEL),
        'mem_w_q': w(ks[17], (D_MODEL, mem_w), D_MODEL),
        'mem_w_k': w(ks[18], (D_MODEL, mem_w), D_MODEL),
        'mem_w_v': w(ks[19], (D_MODEL, mem_w), D_MODEL),
        'mem_q_norm': g(ks[20], MEM_HEAD_DIM),
        'mem_k_norm': g(ks[21], MEM_HEAD_DIM),
        'mem_w_o': w(ks[22], (mem_w, D_MODEL), mem_w),
        'norm_ffn': g(ks[23], D_MODEL),
        'ffn_w_gate': w(ks[24], (D_MODEL, D_FF), D_MODEL),
        'ffn_w_up': w(ks[25], (D_MODEL, D_FF), D_MODEL),
        'ffn_w_down': w(ks[26], (D_FF, D_MODEL), D_FF),
    }


def reference(x, mem, positions, norm_mix, w_in, mla_q_a_norm, mla_w_uq, mla_kv_a_norm, mla_w_ukv,
              mla_q_norm, mla_k_norm, dsa_q_norm, dsa_k_norm, idx_k_norm, w_out, norm_mem_x, norm_mem_kv,
              mem_w_q, mem_w_k, mem_w_v, mem_q_norm, mem_k_norm, mem_w_o, norm_ffn, ffn_w_gate, ffn_w_up,
              ffn_w_down):
    S = x.shape[1]
    top_k = min(INDEX_TOPK_MAX, S // 4)
    cos_m, sin_m = rope_tables(positions, MLA_ROPE_DIM)
    cos_p, sin_p = rope_tables(positions, PARTIAL_ROT_DIM)
    for l in range(DEPTH):
        h = rmsnorm(x, norm_mix[l])
        x = x + hybrid_mixer(h, cos_m, sin_m, cos_p, sin_p, top_k, w_in[l], mla_q_a_norm[l], mla_w_uq[l],
                             mla_kv_a_norm[l], mla_w_ukv[l], mla_q_norm[l], mla_k_norm[l], dsa_q_norm[l],
                             dsa_k_norm[l], idx_k_norm[l], w_out[l])
        x = x + memory_cross_attention(rmsnorm(x, norm_mem_x[l]), rmsnorm(mem, norm_mem_kv[l]), mem_w_q[l],
                                       mem_w_k[l], mem_w_v[l], mem_q_norm[l], mem_k_norm[l], mem_w_o[l])
        x = x + swiglu_ffn(rmsnorm(x, norm_ffn[l]), ffn_w_gate[l], ffn_w_up[l], ffn_w_down[l])
    return x
```

```cpp
#include <hip/hip_runtime.h>
#include <cstdio>
#include <cstdint>
#include <cmath>
namespace pg8 {
#define PG8_LAS __attribute__((address_space(3)))
typedef unsigned short bf16_t;
typedef short bf16x8 __attribute__((ext_vector_type(8)));
typedef float f32x4 __attribute__((ext_vector_type(4)));
typedef unsigned u32x4 __attribute__((ext_vector_type(4)));
constexpr int BM = 256, BK = 64, HALF = 128, HTB = HALF * BK * 2  , STAGE_BYTES = 8 * HTB, NXCD = 8, WGM = 8;

__host__ __device__ __forceinline__ int lds_byte(int r, int c) { const int st = (r >> 4) * 2 + (c >> 5), rr = r & 15, cc = c & 31, ob = rr * 64 + cc * 2; return st * 1024 + (ob ^ (((ob >> 9) & 1) << 5)); }
__host__ __device__ __forceinline__ void stage_rc(int b, int& R, int& C) { const int st = b / 1024, sb = b % 1024, swz = sb ^ (((sb >> 9) & 1) << 5); R = (st >> 1) * 16 + swz / 64; C = (st & 1) * 32 + (swz % 64) / 2; }
__host__ __device__ __forceinline__ int perm32(int rho) { const int n = rho >> 4, i = rho & 15; return 8 * (i >> 2) + 4 * n + (i & 3); }

struct Unit { int pm, pn; };
struct Gemm { const bf16_t* A; const bf16_t* Bt; int M, N, K, lda, ldb, pad; };

struct StaticOrder {
    int nM, nN, nwg, G, c;
    __host__ __device__ void init(int M, int N, int G_, int c_) { nM = M / BM; nN = N / BM; nwg = nM * nN; G = G_; c = c_; }
    __host__ __device__ bool next(int i, Unit& u) const {
        const long L = (long)i * G + c; if (L >= nwg) return false;
        int wgid = (int)L; { const int q = nwg / NXCD, r = nwg % NXCD, xcd = wgid % NXCD, off = wgid / NXCD; wgid = (xcd < r ? xcd * (q + 1) : r * (q + 1) + (xcd - r) * q) + off; }
        const int nig = WGM * nN, gid = wgid / nig, fm = gid * WGM, gsz = (nM - fm) < WGM ? (nM - fm) : WGM;
        u.pm = fm + ((wgid % nig) % gsz); u.pn = (wgid % nig) / gsz; return true;
    }
    __device__ __forceinline__ void a_ready(const Unit&) const {}
    __device__ __forceinline__ void done(const Unit&) const {}
};

__device__ __forceinline__ unsigned cvt_pk_bf16(float lo, float hi) { unsigned r; asm volatile("v_cvt_pk_bf16_f32 %0, %1, %2" : "=v"(r) : "v"(lo), "v"(hi)); return r; }
struct EpiStore {
    static constexpr bool PERM = true, AFTER_DRAIN = false;
    bf16_t* O; int ldc; int pad;
    __device__ __forceinline__ void operator()(const f32x4 (&acc)[2][2][4][2], const Unit& u, int wr, int wc, int fr, int fq) const {
        const int row0 = u.pm * BM + wr * 64 + fr, col0 = u.pn * BM + wc * 32 + 8 * fq;
#pragma unroll
        for (int ai = 0; ai < 2; ++ai)
#pragma unroll
            for (int m = 0; m < 4; ++m) { bf16_t* rowp = O + (size_t)(row0 + ai * HALF + m * 16) * ldc + col0;
#pragma unroll
                for (int bj = 0; bj < 2; ++bj) { const f32x4 v0 = acc[ai][bj][m][0], v1 = acc[ai][bj][m][1];
                    u32x4 w; w.x = cvt_pk_bf16(v0[0], v0[1]); w.y = cvt_pk_bf16(v0[2], v0[3]); w.z = cvt_pk_bf16(v1[0], v1[1]); w.w = cvt_pk_bf16(v1[2], v1[3]);
                    *(u32x4*)(rowp + bj * HALF) = w; } }
    }
};
struct EpiResF32 {
    static constexpr bool PERM = false, AFTER_DRAIN = false;
    const float* base; float* out; int ldc; int pad;
    __device__ __forceinline__ void operator()(const f32x4 (&acc)[2][2][4][2], const Unit& u, int wr, int wc, int fr, int fq) const {
        const int col0 = u.pn * BM + wc * 32 + 4 * fq;
#pragma unroll
        for (int ai = 0; ai < 2; ++ai)
#pragma unroll
            for (int m = 0; m < 4; ++m) { const size_t off = (size_t)(u.pm * BM + ai * HALF + wr * 64 + m * 16 + fr) * ldc + col0;
#pragma unroll
                for (int bj = 0; bj < 2; ++bj)
#pragma unroll
                    for (int n = 0; n < 2; ++n) { const f32x4 b = *(const f32x4*)(base + off + bj * HALF + n * 16); *(f32x4*)(out + off + bj * HALF + n * 16) = b + acc[ai][bj][m][n]; } }
    }
};
struct EpiSwiGLU {
    static constexpr bool PERM = true, AFTER_DRAIN = false;
    bf16_t* H; int ldh; int pad;
    __device__ __forceinline__ void operator()(const f32x4 (&acc)[2][2][4][2], const Unit& u, int wr, int wc, int fr, int fq) const {
        typedef unsigned u32x2v __attribute__((ext_vector_type(2)));
        const int row0 = u.pm * BM + wr * 64 + fr, col0 = (u.pn * BM + wc * 32 + 8 * fq) >> 1;
#pragma unroll
        for (int ai = 0; ai < 2; ++ai)
#pragma unroll
            for (int m = 0; m < 4; ++m) { bf16_t* rowp = H + (size_t)(row0 + ai * HALF + m * 16) * ldh + col0;
#pragma unroll
                for (int bj = 0; bj < 2; ++bj) { const f32x4 g = acc[ai][bj][m][0], up = acc[ai][bj][m][1]; float o[4];
#pragma unroll
                    for (int e = 0; e < 4; ++e) { const float ex = __builtin_amdgcn_exp2f(g[e] * -1.4426950408889634f); o[e] = g[e] * __builtin_amdgcn_rcpf(1.0f + ex) * up[e]; }
                    u32x2v w; w.x = cvt_pk_bf16(o[0], o[1]); w.y = cvt_pk_bf16(o[2], o[3]);
                    *(u32x2v*)(rowp + bj * (HALF / 2)) = w; } }
    }
};
template <class Epi, class Sched, bool ALIGN_EPI = false, bool SP2 = false>
__device__ __forceinline__ void gemm_phase(PG8_LAS unsigned char* lds, const Gemm g, const Sched& S, const Epi& E) {
    const int tid = threadIdx.x, wid = __builtin_amdgcn_readfirstlane(tid >> 6), lane = tid & 63, wr = wid >> 2, wc = wid & 3, fr = lane & 15, fq = lane >> 4;
    const int K = g.K, nt = K / BK;
    unsigned voffA[2], voffB[2];
#pragma unroll
    for (int i = 0; i < 2; ++i) { int R, C; stage_rc(tid * 16 + i * 8192, R, C); const int Rb = Epi::PERM ? ((R & ~31) + perm32(R & 31)) : R;
        voffA[i] = (unsigned)(R * g.lda + C) * 2u; voffB[i] = (unsigned)(Rb * g.ldb + C) * 2u; }
    const size_t kstep = (size_t)(BK * 2);
    const size_t hstepA = (size_t)HALF * g.lda * 2, hstepB = (size_t)HALF * g.ldb * 2;
    const size_t tstepA = 2 * hstepA, tstepB = 2 * hstepB;
    const unsigned ldsw = (unsigned)wid * 1024u;
    const int aoff = lds_byte(wr * 64 + fr, fq * 8), boff = lds_byte(wc * 32 + fr, fq * 8);
#define PG8_SA(b, h) (((b) * 2 + (h)) * HTB)
#define PG8_SB(b, h) ((4 + (b) * 2 + (h)) * HTB)
#define PG8_STAGE(bufoff, gbase, voff) do { _Pragma("unroll") for (int _i = 0; _i < 2; ++_i) \
        __builtin_amdgcn_global_load_lds((const unsigned*)((const char*)(gbase) + (voff)[_i]), (PG8_LAS unsigned*)(lds + (bufoff) + ldsw + _i * 8192), 16, 0, 0); } while (0)
#define PG8_LDA(dst, b, h) do { _Pragma("unroll") for (int m = 0; m < 4; ++m) _Pragma("unroll") for (int k = 0; k < 2; ++k) dst[m][k] = *(const PG8_LAS bf16x8*)(lds + PG8_SA(b, h) + aoff + m * 2048 + k * 1024); } while (0)
#define PG8_LDB(dst, b, h) do { _Pragma("unroll") for (int n = 0; n < 2; ++n) _Pragma("unroll") for (int k = 0; k < 2; ++k) dst[n][k] = *(const PG8_LAS bf16x8*)(lds + PG8_SB(b, h) + boff + n * 2048 + k * 1024); } while (0)
#define PG8_MMA(ai, bj, At, Bt) do { __builtin_amdgcn_s_setprio(1); _Pragma("unroll") for (int m = 0; m < 4; ++m) _Pragma("unroll") for (int n = 0; n < 2; ++n) _Pragma("unroll") for (int k = 0; k < 2; ++k) \
        acc[ai][bj][m][n] = __builtin_amdgcn_mfma_f32_16x16x32_bf16(Bt[n][k], At[m][k], acc[ai][bj][m][n], 0, 0, 0); __builtin_amdgcn_s_setprio(0); } while (0)
#define PG8_WAIT_V(n) asm volatile("s_waitcnt vmcnt(" #n ")" ::: "memory")
#define PG8_WAIT_L(n) asm volatile("s_waitcnt lgkmcnt(" #n ")" ::: "memory")
#define PG8_BAR __builtin_amdgcn_s_barrier()
#define PG8_SCHED __builtin_amdgcn_sched_barrier(0)
    Unit cur, nxt; int ui = 0;
    if (!S.next(0, cur)) return;
    f32x4 acc[2][2][4][2];
#pragma unroll
    for (int a = 0; a < 2; ++a)
#pragma unroll
        for (int b = 0; b < 2; ++b)
#pragma unroll
            for (int m = 0; m < 4; ++m)
#pragma unroll
                for (int n = 0; n < 2; ++n) acc[a][b][m][n] = (f32x4){0.f, 0.f, 0.f, 0.f};
    bf16x8 At[4][2], B0[2][2], B1[2][2];
    const char* cA = (const char*)g.A + (size_t)cur.pm * tstepA; const char* cB = (const char*)g.Bt + (size_t)cur.pn * tstepB;
    S.a_ready(cur);
    if constexpr (SP2) {
        PG8_STAGE(PG8_SB(0, 0), cB, voffB); PG8_STAGE(PG8_SB(0, 1), cB + hstepB, voffB); PG8_STAGE(PG8_SA(0, 0), cA, voffA); PG8_STAGE(PG8_SA(0, 1), cA + hstepA, voffA);
        if (wr == 1) PG8_BAR;
        PG8_WAIT_V(2); PG8_BAR;
        PG8_STAGE(PG8_SB(1, 0), cB + kstep, voffB); PG8_STAGE(PG8_SA(1, 0), cA + kstep, voffA); PG8_STAGE(PG8_SB(1, 1), cB + hstepB + kstep, voffB);
        PG8_WAIT_V(6); PG8_BAR;
    } else {
        PG8_STAGE(PG8_SB(0, 0), cB, voffB); PG8_STAGE(PG8_SA(0, 0), cA, voffA); PG8_STAGE(PG8_SB(0, 1), cB + hstepB, voffB); PG8_STAGE(PG8_SA(0, 1), cA + hstepA, voffA);
        if (wr == 1) PG8_BAR;
        PG8_WAIT_V(4); PG8_BAR;
        PG8_STAGE(PG8_SB(1, 0), cB + kstep, voffB); PG8_STAGE(PG8_SA(1, 0), cA + kstep, voffA); PG8_STAGE(PG8_SB(1, 1), cB + hstepB + kstep, voffB);
        PG8_WAIT_V(6); PG8_BAR;
    }
    for (;;) {
        const bool has_next = S.next(ui + 1, nxt);
        const char* nA = has_next ? (const char*)g.A + (size_t)nxt.pm * tstepA : cA; const char* nB = has_next ? (const char*)g.Bt + (size_t)nxt.pn * tstepB : cB;
        for (int t = 0; t < nt; t += 2) {
            const bool last = (t == nt - 2);
            const char* a1 = cA + (size_t)(t + 1) * kstep;
            const char* a2 = last ? nA : cA + (size_t)(t + 2) * kstep; const char* b2 = last ? nB : cB + (size_t)(t + 2) * kstep;
            const char* a3 = a2 + kstep; const char* b3 = b2 + kstep;
            if (last && has_next) S.a_ready(nxt);
            if constexpr (SP2) {
            PG8_LDB(B0, 0, 0); PG8_LDB(B1, 0, 1); PG8_SCHED; PG8_LDA(At, 0, 0); PG8_STAGE(PG8_SA(1, 1), a1 + hstepA, voffA);
            PG8_WAIT_V(8); PG8_WAIT_L(0); PG8_BAR; PG8_MMA(0, 0, At, B0); PG8_MMA(0, 1, At, B1); PG8_BAR; PG8_SCHED;
            PG8_LDA(At, 0, 1); PG8_STAGE(PG8_SB(0, 0), b2, voffB); PG8_STAGE(PG8_SB(0, 1), b2 + hstepB, voffB); PG8_STAGE(PG8_SA(0, 0), a2, voffA);
            PG8_WAIT_V(8); PG8_WAIT_L(0); PG8_BAR; PG8_MMA(1, 0, At, B0); PG8_MMA(1, 1, At, B1); PG8_BAR; PG8_SCHED;
            PG8_LDB(B0, 1, 0); PG8_LDB(B1, 1, 1); PG8_SCHED; PG8_LDA(At, 1, 0); PG8_STAGE(PG8_SA(0, 1), a2 + hstepA, voffA);
            PG8_WAIT_V(8); PG8_WAIT_L(0); PG8_BAR; PG8_MMA(0, 0, At, B0); PG8_MMA(0, 1, At, B1); PG8_BAR; PG8_SCHED;
            PG8_LDA(At, 1, 1); PG8_STAGE(PG8_SB(1, 0), b3, voffB); PG8_STAGE(PG8_SB(1, 1), b3 + hstepB, voffB); PG8_STAGE(PG8_SA(1, 0), a3, voffA);
            PG8_WAIT_V(8); PG8_WAIT_L(0); PG8_BAR; PG8_MMA(1, 0, At, B0); PG8_MMA(1, 1, At, B1); PG8_BAR; PG8_SCHED;
            } else {
            PG8_LDB(B0, 0, 0); PG8_SCHED; PG8_LDA(At, 0, 0); PG8_STAGE(PG8_SA(1, 1), a1 + hstepA, voffA);
            PG8_WAIT_L(8); PG8_BAR; PG8_WAIT_L(0); PG8_MMA(0, 0, At, B0); PG8_BAR; PG8_SCHED;
            PG8_LDB(B1, 0, 1); PG8_STAGE(PG8_SB(0, 0), b2, voffB);
            PG8_BAR; PG8_WAIT_L(0); PG8_MMA(0, 1, At, B1); PG8_BAR;
            PG8_LDA(At, 0, 1); PG8_STAGE(PG8_SA(0, 0), a2, voffA);
            PG8_BAR; PG8_WAIT_L(0); PG8_MMA(1, 0, At, B0); PG8_BAR; PG8_SCHED;
            PG8_STAGE(PG8_SB(0, 1), b2 + hstepB, voffB);
            PG8_WAIT_V(6); PG8_BAR; PG8_MMA(1, 1, At, B1); PG8_BAR;
            PG8_LDB(B0, 1, 0); PG8_SCHED; PG8_LDA(At, 1, 0); PG8_STAGE(PG8_SA(0, 1), a2 + hstepA, voffA);
            PG8_WAIT_L(8); PG8_BAR; PG8_WAIT_L(0); PG8_MMA(0, 0, At, B0); PG8_BAR; PG8_SCHED;
            PG8_LDB(B1, 1, 1); PG8_STAGE(PG8_SB(1, 0), b3, voffB);
            PG8_BAR; PG8_WAIT_L(0); PG8_MMA(0, 1, At, B1); PG8_BAR;
            PG8_LDA(At, 1, 1); PG8_STAGE(PG8_SA(1, 0), a3, voffA);
            PG8_BAR; PG8_WAIT_L(0); PG8_MMA(1, 0, At, B0); PG8_BAR; PG8_SCHED;
            PG8_STAGE(PG8_SB(1, 1), b3 + hstepB, voffB);
            PG8_WAIT_V(6); PG8_BAR; PG8_MMA(1, 1, At, B1); PG8_BAR;
            }
        }
        if constexpr (ALIGN_EPI) { if (wr == 0) PG8_BAR; }
        if constexpr (!Epi::AFTER_DRAIN) { E(acc, cur, wr, wc, fr, fq); S.done(cur); }
        if (!has_next) break;
#pragma unroll
        for (int a = 0; a < 2; ++a)
#pragma unroll
            for (int b = 0; b < 2; ++b)
#pragma unroll
                for (int m = 0; m < 4; ++m)
#pragma unroll
                    for (int n = 0; n < 2; ++n) acc[a][b][m][n] = (f32x4){0.f, 0.f, 0.f, 0.f};
        cur = nxt; cA = nA; cB = nB; ++ui;
        if constexpr (ALIGN_EPI) { if (wr == 1) PG8_BAR; }
    }
    PG8_WAIT_V(0);
    if constexpr (!ALIGN_EPI) { if (wr == 0) PG8_BAR; }
    PG8_BAR;
    if constexpr (Epi::AFTER_DRAIN) { E.fused(acc, cur, wr, wc, fr, fq, lds, wid, lane); S.done(cur); }
#undef PG8_SA
#undef PG8_SB
#undef PG8_STAGE
#undef PG8_LDA
#undef PG8_LDB
#undef PG8_MMA
#undef PG8_WAIT_V
#undef PG8_WAIT_L
#undef PG8_BAR
#undef PG8_SCHED
}
}

constexpr int BATCH = 4, SEQ = 8192, DM = 1024, M = BATCH * SEQ, NMEM = 256;
constexpr int PP = 1792;
constexpr int C_CQ = 0, C_CKV = 256, C_KPE = 384, C_QD = 416, C_KD = 928, C_VD = 1056, C_QI = 1184, C_KI = 1696, C_WI = 1760, IN_COLS = 1768;
constexpr int DFF = 2816;
constexpr float EPS = 1e-6f, LOG2E = 1.4426950408889634f;
constexpr float SC_MLA = 0.10206207261596577f * LOG2E;
constexpr float SC_DSA = 0.125f * LOG2E;
constexpr float SC_MEM = 0.08838834764831845f * LOG2E;
constexpr float SC_IDX = 0.125f;
constexpr int ROPE_W = 48;

typedef unsigned short bf16_t;
typedef unsigned u32x4 __attribute__((ext_vector_type(4)));
typedef unsigned u32x2 __attribute__((ext_vector_type(2)));
typedef float f32x4 __attribute__((ext_vector_type(4)));
#define LAS __attribute__((address_space(3)))

constexpr size_t MiB = 1u << 20;
constexpr size_t WS_CTL = 0;
constexpr size_t WS_WIN = 1 * MiB;
constexpr size_t WS_WUQ = WS_WIN + (size_t)PP * 1024 * 2;
constexpr size_t WS_WUKV = WS_WUQ + 768 * 256 * 2;
constexpr size_t WS_WOUT = WS_WUKV + 1024 * 128 * 2;
constexpr size_t WS_WMQ = WS_WOUT + 1024 * 1024 * 2;
constexpr size_t WS_WMKV = WS_WMQ + 512 * 1024 * 2;
constexpr size_t WS_WMO = WS_WMKV + 1024 * 1024 * 2;
constexpr size_t WS_WGU = WS_WMO + 1024 * 512 * 2;
constexpr size_t WS_WDN = WS_WGU + (size_t)5632 * 1024 * 2;
constexpr size_t WS_WEND = WS_WDN + (size_t)1024 * 2816 * 2;
static_assert(WS_WEND <= 29 * MiB, "weights");
constexpr size_t WS_ROPE = 29 * MiB;
constexpr size_t WS_MEMN = 35 * MiB;
constexpr size_t WS_KVC = 37 * MiB;
constexpr size_t WS_WI = 39 * MiB;
constexpr size_t WS_KI = 40 * MiB;
constexpr size_t WS_KVD = 44 * MiB;
constexpr size_t WS_SEL = 60 * MiB;
constexpr size_t WS_XN = 76 * MiB;
constexpr size_t WS_MIX = 140 * MiB;
constexpr size_t WS_QC = WS_MIX;
constexpr size_t WS_PROJ = 204 * MiB;
constexpr size_t WS_QM = 316 * MiB;
constexpr size_t WS_KVM = 364 * MiB;
constexpr size_t WS_KM = 428 * MiB;
constexpr size_t WS_H = 204 * MiB;
constexpr size_t WS_END = 476 * MiB;
static_assert(WS_H + (size_t)M * DFF * 2 <= WS_KM, "H overlay");

__device__ __forceinline__ unsigned f2bf(float f) { unsigned u = __builtin_bit_cast(unsigned, f); return (u + 0x7fffu + ((u >> 16) & 1u)) >> 16; }
__device__ __forceinline__ unsigned pk2(float lo, float hi) { return f2bf(lo) | (f2bf(hi) << 16); }
__device__ __forceinline__ float bf2f(unsigned short h) { return __builtin_bit_cast(float, (unsigned)h << 16); }
__device__ __forceinline__ float bflo(unsigned w) { return __builtin_bit_cast(float, w << 16); }
__device__ __forceinline__ float bfhi(unsigned w) { return __builtin_bit_cast(float, w & 0xffff0000u); }
__device__ __forceinline__ float wave_sum(float v) {
#pragma unroll
    for (int o = 1; o < 64; o <<= 1) v += __shfl_xor(v, o);
    return v;
}
__device__ __forceinline__ float wave_max(float v) {
#pragma unroll
    for (int o = 1; o < 64; o <<= 1) v = fmaxf(v, __shfl_xor(v, o));
    return v;
}

__device__ __forceinline__ int wt_dst_row(int c, int mode, int row_off) { return mode == 0 ? row_off + c : ((c >> 2) * 8 + (c & 3) + row_off); }
__device__ __forceinline__ void transpose_item(const float* W, int K, int Nsrc, bf16_t* WT, int mode, int row_off, const float* gk, LAS float* scr, int kb, int nb, int lane) {
    const int k0 = 64 * kb, n0 = 32 * nb;
    const int c = n0 + (lane & 31);
#pragma unroll 8
    for (int i = 0; i < 32; ++i) { const int kk = 2 * i + (lane >> 5); float v = (c < Nsrc) ? W[(size_t)(k0 + kk) * Nsrc + c] : 0.f; if (gk) v *= gk[k0 + kk]; scr[kk * 33 + (lane & 31)] = v; }
    asm volatile("s_waitcnt lgkmcnt(0)" ::: "memory");
    const int ch = lane & 7;
#pragma unroll
    for (int j = 0; j < 4; ++j) { const int n = (lane >> 3) + 8 * j; const LAS float* s = scr + (8 * ch) * 33 + n;
        u32x4 o; o.x = pk2(s[0 * 33], s[1 * 33]); o.y = pk2(s[2 * 33], s[3 * 33]); o.z = pk2(s[4 * 33], s[5 * 33]); o.w = pk2(s[6 * 33], s[7 * 33]);
        *(u32x4*)(WT + (size_t)wt_dst_row(n0 + n, mode, row_off) * K + k0 + 8 * ch) = o; }
    asm volatile("s_waitcnt lgkmcnt(0)" ::: "memory");
}
struct WtJob { const float* W; bf16_t* WT; const float* gk; int K, Nsrc, Ncover, mode, row_off, pad; };
constexpr int N_WT_JOBS = 11;
struct WtJobs { WtJob j[N_WT_JOBS]; };
__global__ void __launch_bounds__(256) k_weights(WtJobs jobs) {
    __shared__ float scr_all[4][64 * 33];
    const int lane = threadIdx.x & 63, wave = threadIdx.x >> 6;
    LAS float* scr = (LAS float*)scr_all[wave];
    const int gw = blockIdx.x * 4 + wave, NGW = gridDim.x * 4;
    for (int ji = 0; ji < N_WT_JOBS; ++ji) {
        const WtJob jb = jobs.j[ji];
        const int nkb = jb.K / 64, nnb = jb.Ncover / 32, nitems = nkb * nnb;
        for (int it = gw; it < nitems; it += NGW) transpose_item(jb.W, jb.K, jb.Nsrc, jb.WT, jb.mode, jb.row_off, jb.gk, scr, it / nnb, it % nnb, lane);
    }
}
__device__ __forceinline__ void rms_row_1024(const float* xrow, const float* g, bf16_t* orow, int lane) {
    const f32x4* xr = (const f32x4*)xrow + lane; const f32x4* gr = (const f32x4*)g + lane;
    f32x4 v[4]; float s = 0.f;
#pragma unroll
    for (int j = 0; j < 4; ++j) { v[j] = xr[64 * j]; s += (v[j].x * v[j].x + v[j].y * v[j].y) + (v[j].z * v[j].z + v[j].w * v[j].w); }
    const float rstd = 1.0f / sqrtf(wave_sum(s) * (1.f / 1024.f) + EPS);
    unsigned long long* o8 = (unsigned long long*)orow + lane;
#pragma unroll
    for (int j = 0; j < 4; ++j) { const f32x4 gg = gr[64 * j]; o8[64 * j] = (unsigned long long)pk2(v[j].x * rstd * gg.x, v[j].y * rstd * gg.y) | ((unsigned long long)pk2(v[j].z * rstd * gg.z, v[j].w * rstd * gg.w) << 32); }
}
__global__ void __launch_bounds__(256) k_rmsnorm_rows(const float* X, const float* g, bf16_t* O, int R) {
    const int lane = threadIdx.x & 63, gw = blockIdx.x * 4 + (threadIdx.x >> 6), NGW = gridDim.x * 4;
    for (int r = gw; r < R; r += NGW) rms_row_1024(X + (size_t)r * 1024, g, O + (size_t)r * 1024, lane);
}
__global__ void __launch_bounds__(256) k_rope(const int* pos, float* tab) {
    const int i = blockIdx.x * 256 + threadIdx.x; if (i >= M * 24) return;
    const int tok = i / 24, j = i % 24;
    const float e = (j < 16) ? (float)j * (1.0f / 16.0f) : (float)(j - 16) * (1.0f / 8.0f);
    const float inv = exp2f(-e * 18.931568569324174f);
    const float ang = (float)pos[tok] * inv;
    const double rev = (double)ang * 0.15915494309189535; const float fr = (float)(rev - rint(rev));
    const float c = __builtin_amdgcn_cosf(fr), s = __builtin_amdgcn_sinf(fr);
    float* t = tab + (size_t)tok * ROPE_W;
    if (j < 16) { t[j] = c; t[16 + j] = s; } else { t[32 + (j - 16)] = c; t[40 + (j - 16)] = s; }
}

struct Post1Args { bf16_t* proj; bf16_t* kvd; bf16_t* ki; float* wi; const float* rope; const float* g_dq; const float* g_dk; const float* g_ik; };
__global__ void __launch_bounds__(256) k_post1(Post1Args a) {
    __shared__ float rowbuf[4][PP];
    const int lane = threadIdx.x & 63, wave = threadIdx.x >> 6;
    float* rb = rowbuf[wave];
    const int gw = blockIdx.x * 4 + wave, NGW = gridDim.x * 4;
    for (int tok = gw; tok < M; tok += NGW) {
        bf16_t* prow = a.proj + (size_t)tok * PP;
        const float* rt = a.rope + (size_t)tok * ROPE_W; const float* cp = rt + 32; const float* sp = rt + 40;
        for (int c = lane; c < PP / 8; c += 64) { const u32x4 w = *(const u32x4*)(prow + c * 8); float* d = rb + c * 8;
            d[0] = bflo(w.x); d[1] = bfhi(w.x); d[2] = bflo(w.y); d[3] = bfhi(w.y); d[4] = bflo(w.z); d[5] = bfhi(w.z); d[6] = bflo(w.w); d[7] = bfhi(w.w); }
        __builtin_amdgcn_s_waitcnt(0); __builtin_amdgcn_wave_barrier();
        { float s = 0.f; for (int i = lane; i < 256; i += 64) s += rb[C_CQ + i] * rb[C_CQ + i]; const float r = 1.0f / sqrtf(wave_sum(s) * (1.f / 256.f) + EPS);
          for (int i = lane; i < 256; i += 64) rb[C_CQ + i] *= r; }
        { float s = 0.f; for (int i = lane; i < 128; i += 64) s += rb[C_CKV + i] * rb[C_CKV + i]; const float r = 1.0f / sqrtf(wave_sum(s) * (1.f / 128.f) + EPS);
          for (int i = lane; i < 128; i += 64) rb[C_CKV + i] *= r; }
        for (int hb = 0; hb < 19; hb += 8) {
            const int hh = hb + (lane >> 3), sub = lane & 7;
            if (hh < 19) {
                int base; const float* g; float sc; bool nrm;
                if (hh < 8) { base = C_QD + 64 * hh; g = a.g_dq; sc = SC_DSA; nrm = true; }
                else if (hh < 10) { base = C_KD + 64 * (hh - 8); g = a.g_dk; sc = 1.f; nrm = true; }
                else if (hh < 18) { base = C_QI + 64 * (hh - 10); g = nullptr; sc = SC_IDX; nrm = false; }
                else { base = C_KI; g = a.g_ik; sc = 1.f; nrm = true; }
                float v[8]; float s = 0.f;
#pragma unroll
                for (int e = 0; e < 8; ++e) { v[e] = rb[base + sub * 8 + e]; s += v[e] * v[e]; }
                s += __shfl_xor(s, 1); s += __shfl_xor(s, 2); s += __shfl_xor(s, 4);
                const float r = nrm ? 1.0f / sqrtf(s * (1.f / 64.f) + EPS) : 1.0f;
#pragma unroll
                for (int e = 0; e < 8; ++e) { v[e] *= r; if (g) v[e] *= g[sub * 8 + e]; }
#pragma unroll
                for (int e = 0; e < 8; ++e) { const float o = __shfl_xor(v[e], 1);
                    if (sub == 0) v[e] = v[e] * cp[e] - o * sp[e]; else if (sub == 1) v[e] = v[e] * cp[e] + o * sp[e]; }
#pragma unroll
                for (int e = 0; e < 8; ++e) rb[base + sub * 8 + e] = v[e] * sc;
            }
        }
        __builtin_amdgcn_s_waitcnt(0); __builtin_amdgcn_wave_barrier();
        for (int c = lane; c < PP / 8; c += 64) { const float* d = rb + c * 8; u32x4 w; w.x = pk2(d[0], d[1]); w.y = pk2(d[2], d[3]); w.z = pk2(d[4], d[5]); w.w = pk2(d[6], d[7]); *(u32x4*)(prow + c * 8) = w; }
        if (lane < 32) { const float* d = rb + C_KD + lane * 8; u32x4 w; w.x = pk2(d[0], d[1]); w.y = pk2(d[2], d[3]); w.z = pk2(d[4], d[5]); w.w = pk2(d[6], d[7]); *(u32x4*)(a.kvd + (size_t)tok * 256 + lane * 8) = w; }
        if (lane < 8) { const float* d = rb + C_KI + lane * 8; u32x4 w; w.x = pk2(d[0], d[1]); w.y = pk2(d[2], d[3]); w.z = pk2(d[4], d[5]); w.w = pk2(d[6], d[7]); *(u32x4*)(a.ki + (size_t)tok * 64 + lane * 8) = w; }
        if (lane < 8) a.wi[(size_t)tok * 8 + lane] = rb[C_WI + lane] * 0.35355339059327373f;
        __builtin_amdgcn_s_waitcnt(0); __builtin_amdgcn_wave_barrier();
    }
}
struct Post2Args { bf16_t* qm; const bf16_t* kvm; const bf16_t* proj; bf16_t* km; const float* rope; const float* g_q; const float* g_k; };
__global__ void __launch_bounds__(256) k_post2(Post2Args a) {
    __shared__ float rowbuf[4][2][768];
    const int lane = threadIdx.x & 63, wave = threadIdx.x >> 6;
    float* qb = rowbuf[wave][0]; float* kb = rowbuf[wave][1];
    const int gw = blockIdx.x * 4 + wave, NGW = gridDim.x * 4;
    for (int tok = gw; tok < M; tok += NGW) {
        bf16_t* qrow = a.qm + (size_t)tok * 768; const bf16_t* kvrow = a.kvm + (size_t)tok * 1024; const bf16_t* pe = a.proj + (size_t)tok * PP + C_KPE;
        const float* rt = a.rope + (size_t)tok * ROPE_W; const float* cm = rt; const float* sm = rt + 16;
        for (int c = lane; c < 96; c += 64) { const u32x4 w = *(const u32x4*)(qrow + c * 8); float* d = qb + c * 8;
            d[0] = bflo(w.x); d[1] = bfhi(w.x); d[2] = bflo(w.y); d[3] = bfhi(w.y); d[4] = bflo(w.z); d[5] = bfhi(w.z); d[6] = bflo(w.w); d[7] = bfhi(w.w); }
        for (int c = lane; c < 96; c += 64) { const int h = c / 12, j = c % 12; const u32x4 w = (j < 8) ? *(const u32x4*)(kvrow + 128 * h + j * 8) : *(const u32x4*)(pe + (j - 8) * 8); float* d = kb + h * 96 + j * 8;
            d[0] = bflo(w.x); d[1] = bfhi(w.x); d[2] = bflo(w.y); d[3] = bfhi(w.y); d[4] = bflo(w.z); d[5] = bfhi(w.z); d[6] = bflo(w.w); d[7] = bfhi(w.w); }
        __builtin_amdgcn_s_waitcnt(0); __builtin_amdgcn_wave_barrier();
        { const int h = lane >> 3, sub = lane & 7; float sq = 0.f, sk = 0.f;
#pragma unroll
          for (int e = 0; e < 12; ++e) { const float x = qb[h * 96 + sub * 12 + e], y = kb[h * 96 + sub * 12 + e]; sq += x * x; sk += y * y; }
          sq += __shfl_xor(sq, 1); sq += __shfl_xor(sq, 2); sq += __shfl_xor(sq, 4); sk += __shfl_xor(sk, 1); sk += __shfl_xor(sk, 2); sk += __shfl_xor(sk, 4);
          const float rq = 1.0f / sqrtf(sq * (1.f / 96.f) + EPS), rk = 1.0f / sqrtf(sk * (1.f / 96.f) + EPS);
#pragma unroll
          for (int e = 0; e < 12; ++e) { const int d = sub * 12 + e; qb[h * 96 + d] *= rq * a.g_q[d]; kb[h * 96 + d] *= rk * a.g_k[d]; } }
        __builtin_amdgcn_s_waitcnt(0); __builtin_amdgcn_wave_barrier();
#pragma unroll
        for (int p = 0; p < 2; ++p) { const int pi = lane + 64 * p, h = pi >> 4, i = pi & 15; const float c = cm[i], s = sm[i];
            { const float x1 = qb[h * 96 + 64 + i], x2 = qb[h * 96 + 80 + i]; qb[h * 96 + 64 + i] = x1 * c - x2 * s; qb[h * 96 + 80 + i] = x2 * c + x1 * s; }
            { const float x1 = kb[h * 96 + 64 + i], x2 = kb[h * 96 + 80 + i]; kb[h * 96 + 64 + i] = x1 * c - x2 * s; kb[h * 96 + 80 + i] = x2 * c + x1 * s; } }
        __builtin_amdgcn_s_waitcnt(0); __builtin_amdgcn_wave_barrier();
        bf16_t* krow = a.km + (size_t)tok * 768;
        for (int c = lane; c < 96; c += 64) { const float* d = qb + c * 8; u32x4 w; w.x = pk2(d[0] * SC_MLA, d[1] * SC_MLA); w.y = pk2(d[2] * SC_MLA, d[3] * SC_MLA); w.z = pk2(d[4] * SC_MLA, d[5] * SC_MLA); w.w = pk2(d[6] * SC_MLA, d[7] * SC_MLA); *(u32x4*)(qrow + c * 8) = w;
            const float* e = kb + c * 8; u32x4 x; x.x = pk2(e[0], e[1]); x.y = pk2(e[2], e[3]); x.z = pk2(e[4], e[5]); x.w = pk2(e[6], e[7]); *(u32x4*)(krow + c * 8) = x; }
        __builtin_amdgcn_s_waitcnt(0); __builtin_amdgcn_wave_barrier();
    }
}
__global__ void __launch_bounds__(256) k_headnorm128(bf16_t* X, int R, int pitch, int col0, int nheads, const float* g, float sc) {
    const int lane = threadIdx.x & 63, gw = blockIdx.x * 4 + (threadIdx.x >> 6), NGW = gridDim.x * 4;
    const int per_row = nheads / 4;
    for (int it = gw; it < R * per_row; it += NGW) {
        const int r = it / per_row, h = (it % per_row) * 4 + (lane >> 4), sub = lane & 15;
        bf16_t* p = X + (size_t)r * pitch + col0 + h * 128 + sub * 8;
        const u32x4 w = *(const u32x4*)p; float v[8] = {bflo(w.x), bfhi(w.x), bflo(w.y), bfhi(w.y), bflo(w.z), bfhi(w.z), bflo(w.w), bfhi(w.w)};
        float s = 0.f;
#pragma unroll
        for (int e = 0; e < 8; ++e) s += v[e] * v[e];
        s += __shfl_xor(s, 1); s += __shfl_xor(s, 2); s += __shfl_xor(s, 4); s += __shfl_xor(s, 8);
        const float rr = sc / sqrtf(s * (1.f / 128.f) + EPS);
#pragma unroll
        for (int e = 0; e < 8; ++e) v[e] *= rr * g[sub * 8 + e];
        u32x4 o; o.x = pk2(v[0], v[1]); o.y = pk2(v[2], v[3]); o.z = pk2(v[4], v[5]); o.w = pk2(v[6], v[7]); *(u32x4*)p = o;
    }
}

struct AttnArgs { const bf16_t* Q; const bf16_t* K; const bf16_t* V; bf16_t* O; const unsigned short* sel;
                  int q_pitch, q_hs, k_pitch, k_hs, v_pitch, v_hs, o_pitch, o_hs, H, kv_group, mode, n_mem; };
template <int DQK, int DV> __global__ void __launch_bounds__(256) k_attn_naive(AttnArgs a) {
    __shared__ float qs_all[4][DQK];
    const int lane = threadIdx.x & 63, wave = threadIdx.x >> 6;
    float* qs = qs_all[wave];
    const long wid = (long)blockIdx.x * 4 + wave;
    if (wid >= (long)M * a.H) return;
    const int row = (int)(wid / a.H), h = (int)(wid % a.H), b = row / SEQ, t = row % SEQ, kvh = h / a.kv_group;
    const bf16_t* q = a.Q + (size_t)row * a.q_pitch + h * a.q_hs;
    for (int d = lane; d < DQK; d += 64) qs[d] = bf2f(q[d]);
    __builtin_amdgcn_s_waitcnt(0); __builtin_amdgcn_wave_barrier();
    const int n = a.mode == 0 ? t + 1 : (a.mode == 1 ? a.n_mem : 256);
    const long kbase = a.mode == 1 ? (long)b * a.n_mem : (long)b * SEQ;
    float mrun = -INFINITY, l = 0.f, acc[DV / 64];
#pragma unroll
    for (int i = 0; i < DV / 64; ++i) acc[i] = 0.f;
    for (int c0 = 0; c0 < n; c0 += 64) {
        const int j = c0 + lane; bool valid = j < n; long krow = kbase;
        if (valid) { if (a.mode == 2) { const unsigned idx = a.sel[(size_t)row * 256 + j]; valid = idx != 0xFFFFu && (int)idx <= t; krow = kbase + (valid ? idx : 0); } else krow = kbase + j; }
        float s = -INFINITY;
        if (valid) { const bf16_t* kp = a.K + (size_t)krow * a.k_pitch + kvh * a.k_hs; float d0 = 0.f;
#pragma unroll
            for (int c = 0; c < DQK / 8; ++c) { const u32x4 w = *(const u32x4*)(kp + c * 8); const float* qq = qs + c * 8;
                d0 += qq[0] * bflo(w.x) + qq[1] * bfhi(w.x) + qq[2] * bflo(w.y) + qq[3] * bfhi(w.y) + qq[4] * bflo(w.z) + qq[5] * bfhi(w.z) + qq[6] * bflo(w.w) + qq[7] * bfhi(w.w); }
            s = d0; }
        const float cmx = wave_max(s);
        if (cmx == -INFINITY) continue;
        const float mnew = fmaxf(mrun, cmx);
        const float alpha = (mrun == -INFINITY) ? 0.f : exp2f(mrun - mnew);
        const float p = valid ? exp2f(s - mnew) : 0.f;
        l = l * alpha + wave_sum(p);
#pragma unroll
        for (int i = 0; i < DV / 64; ++i) acc[i] *= alpha;
        mrun = mnew;
        const int cnt = (n - c0) < 64 ? (n - c0) : 64;
        for (int jj = 0; jj < cnt; ++jj) {
            const float pj = __shfl(p, jj); const long rj = __shfl((int)(krow - kbase), jj) + kbase;
            if (pj != 0.f) { const bf16_t* vp = a.V + (size_t)rj * a.v_pitch + kvh * a.v_hs;
#pragma unroll
                for (int i = 0; i < DV / 64; ++i) acc[i] += pj * bf2f(vp[lane + 64 * i]); }
        }
    }
    bf16_t* o = a.O + (size_t)row * a.o_pitch + h * a.o_hs;
    const float il = 1.0f / l;
#pragma unroll
    for (int i = 0; i < DV / 64; ++i) o[lane + 64 * i] = (bf16_t)f2bf(acc[i] * il);
}

__device__ __forceinline__ unsigned mono_key(float s) { const unsigned u = __builtin_bit_cast(unsigned, s + 0.0f); return (u & 0x80000000u) ? ~u : (u | 0x80000000u); }
__global__ void __launch_bounds__(256) k_index_naive(const bf16_t* proj, const bf16_t* Ki, const float* Wi, unsigned short* SEL) {
    __shared__ unsigned keys[SEQ]; __shared__ float qs[512]; __shared__ float ws[8]; __shared__ int red[2][4]; __shared__ int cgt[256], ceq[256];
    const int tid = threadIdx.x, lane = tid & 63, wave = tid >> 6;
    const int row = blockIdx.x, b = row / SEQ, t = row % SEQ, n = t + 1;
    unsigned short* out = SEL + (size_t)row * 256;
    if (n <= 256) { out[tid] = tid < n ? (unsigned short)tid : (unsigned short)0xFFFFu; return; }
    for (int i = tid; i < 512; i += 256) qs[i] = bf2f(proj[(size_t)row * PP + C_QI + i]);
    if (tid < 8) ws[tid] = Wi[(size_t)row * 8 + tid];
    __syncthreads();
    for (int j = tid; j < n; j += 256) {
        const bf16_t* kp = Ki + ((size_t)b * SEQ + j) * 64; float kf[64];
#pragma unroll
        for (int c = 0; c < 8; ++c) { const u32x4 w = *(const u32x4*)(kp + c * 8); kf[c * 8 + 0] = bflo(w.x); kf[c * 8 + 1] = bfhi(w.x); kf[c * 8 + 2] = bflo(w.y); kf[c * 8 + 3] = bfhi(w.y); kf[c * 8 + 4] = bflo(w.z); kf[c * 8 + 5] = bfhi(w.z); kf[c * 8 + 6] = bflo(w.w); kf[c * 8 + 7] = bfhi(w.w); }
        float sc = 0.f;
#pragma unroll
        for (int h = 0; h < 8; ++h) { float d = 0.f;
#pragma unroll
            for (int i = 0; i < 64; ++i) d += qs[h * 64 + i] * kf[i];
            sc += ws[h] * fmaxf(d, 0.f); }
        keys[j] = mono_key(sc);
    }
    __syncthreads();
    unsigned T = 0u;
    for (int bit = 31; bit >= 0; --bit) {
        const unsigned cand = T | (1u << bit); int c = 0;
        for (int j = tid; j < n; j += 256) c += keys[j] >= cand ? 1 : 0;
#pragma unroll
        for (int o = 1; o < 64; o <<= 1) c += __shfl_xor(c, o);
        if (lane == 0) red[bit & 1][wave] = c;
        __syncthreads();
        const int tot = red[bit & 1][0] + red[bit & 1][1] + red[bit & 1][2] + red[bit & 1][3];
        if (tot >= 256) T = cand;
    }
    const int j0 = tid * 32; int ngt = 0, neq = 0;
    for (int j = j0; j < j0 + 32 && j < n; ++j) { const unsigned k = keys[j]; ngt += k > T; neq += k == T; }
    cgt[tid] = ngt; ceq[tid] = neq;
    __syncthreads();
    int tot_gt = 0; for (int i = 0; i < 256; ++i) tot_gt += cgt[i];
    const int r = 256 - tot_gt;
    int pe = 0, off = 0;
    for (int i = 0; i < tid; ++i) { const int rem = r - pe; const int take = rem <= 0 ? 0 : (ceq[i] < rem ? ceq[i] : rem); off += cgt[i] + take; pe += ceq[i]; }
    for (int j = j0; j < j0 + 32 && j < n; ++j) { const unsigned k = keys[j];
        if (k > T) out[off++] = (unsigned short)j; else if (k == T) { if (pe < r) out[off++] = (unsigned short)j; ++pe; } }
}

template <class Epi> __global__ void __launch_bounds__(512, 2) k_gemm(pg8::Gemm g, Epi E) {
    extern __shared__ __attribute__((aligned(16))) unsigned char lds[];
    pg8::StaticOrder S; S.init(g.M, g.N, (int)gridDim.x, (int)blockIdx.x);
    pg8::gemm_phase<Epi, pg8::StaticOrder, true, true>((PG8_LAS unsigned char*)lds, g, S, E);
}
constexpr int GEMM_LDS = pg8::STAGE_BYTES;
template <class Epi> static void launch_gemm(const bf16_t* A, int lda, const bf16_t* Bt, int ldb, int Mr, int N, int K, const Epi& E, hipStream_t st) {
    static bool attr_done = false;
    if (!attr_done) { (void)hipFuncSetAttribute((const void*)k_gemm<Epi>, hipFuncAttributeMaxDynamicSharedMemorySize, GEMM_LDS); attr_done = true; }
    pg8::Gemm g{}; g.A = A; g.Bt = Bt; g.M = Mr; g.N = N; g.K = K; g.lda = lda; g.ldb = ldb; g.pad = 0;
    hipLaunchKernelGGL(k_gemm<Epi>, dim3(256), dim3(512), GEMM_LDS, st, g, E);
}

extern "C" void kernel_launch(void* const* d_in, const int* in_sizes, int n_in, void* d_out, int out_size, void* d_ws, size_t ws_size, hipStream_t stream) {
    if (n_in != 27 || in_sizes[0] != M * DM || out_size != M * DM || ws_size < WS_END) { fprintf(stderr, "kernel_launch: unexpected shapes (n_in %d, in0 %d, out %d, ws %zu)\n", n_in, n_in > 0 ? in_sizes[0] : -1, out_size, ws_size); return; }
    const float* x = (const float*)d_in[0]; const float* mem = (const float*)d_in[1]; const int* pos = (const int*)d_in[2];
    const float* norm_mix = (const float*)d_in[3]; const float* w_in = (const float*)d_in[4]; const float* g_qa = (const float*)d_in[5]; const float* w_uq = (const float*)d_in[6];
    const float* g_kva = (const float*)d_in[7]; const float* w_ukv = (const float*)d_in[8]; const float* g_mq = (const float*)d_in[9]; const float* g_mk = (const float*)d_in[10];
    const float* g_dq = (const float*)d_in[11]; const float* g_dk = (const float*)d_in[12]; const float* g_ik = (const float*)d_in[13]; const float* w_out = (const float*)d_in[14];
    const float* norm_mem_x = (const float*)d_in[15]; const float* norm_mem_kv = (const float*)d_in[16]; const float* mw_q = (const float*)d_in[17]; const float* mw_k = (const float*)d_in[18];
    const float* mw_v = (const float*)d_in[19]; const float* g_cq = (const float*)d_in[20]; const float* g_ck = (const float*)d_in[21]; const float* mw_o = (const float*)d_in[22];
    const float* norm_ffn = (const float*)d_in[23]; const float* w_gate = (const float*)d_in[24]; const float* w_up = (const float*)d_in[25]; const float* w_down = (const float*)d_in[26];
    unsigned char* ws = (unsigned char*)d_ws; float* out = (float*)d_out;
    bf16_t* Win = (bf16_t*)(ws + WS_WIN); bf16_t* Wuq = (bf16_t*)(ws + WS_WUQ); bf16_t* Wukv = (bf16_t*)(ws + WS_WUKV); bf16_t* Wout = (bf16_t*)(ws + WS_WOUT);
    bf16_t* Wmq = (bf16_t*)(ws + WS_WMQ); bf16_t* Wmkv = (bf16_t*)(ws + WS_WMKV); bf16_t* Wmo = (bf16_t*)(ws + WS_WMO); bf16_t* Wgu = (bf16_t*)(ws + WS_WGU); bf16_t* Wdn = (bf16_t*)(ws + WS_WDN);
    float* rope = (float*)(ws + WS_ROPE); bf16_t* memn = (bf16_t*)(ws + WS_MEMN); bf16_t* kvc = (bf16_t*)(ws + WS_KVC); float* wi = (float*)(ws + WS_WI); bf16_t* ki = (bf16_t*)(ws + WS_KI);
    bf16_t* kvd = (bf16_t*)(ws + WS_KVD); unsigned short* sel = (unsigned short*)(ws + WS_SEL); bf16_t* xn = (bf16_t*)(ws + WS_XN); bf16_t* mix = (bf16_t*)(ws + WS_MIX); bf16_t* qc = (bf16_t*)(ws + WS_QC);
    bf16_t* proj = (bf16_t*)(ws + WS_PROJ); bf16_t* qm = (bf16_t*)(ws + WS_QM); bf16_t* kvm = (bf16_t*)(ws + WS_KVM); bf16_t* km = (bf16_t*)(ws + WS_KM); bf16_t* hb = (bf16_t*)(ws + WS_H);

    WtJobs jobs{};
    auto setjob = [&](int i, const float* W, bf16_t* WT, const float* gk, int K, int Nsrc, int Ncover, int mode, int row_off) { WtJob& j = jobs.j[i]; j.W = W; j.WT = WT; j.gk = gk; j.K = K; j.Nsrc = Nsrc; j.Ncover = Ncover; j.mode = mode; j.row_off = row_off; j.pad = 0; };
    setjob(0, w_in, Win, nullptr, 1024, IN_COLS, PP, 0, 0);
    setjob(1, w_uq, Wuq, g_qa, 256, 768, 768, 0, 0);
    setjob(2, w_ukv, Wukv, g_kva, 128, 1024, 1024, 0, 0);
    setjob(3, w_out, Wout, nullptr, 1024, 1024, 1024, 0, 0);
    setjob(4, mw_q, Wmq, nullptr, 1024, 512, 512, 0, 0);
    setjob(5, mw_k, Wmkv, nullptr, 1024, 512, 512, 0, 0);
    setjob(6, mw_v, Wmkv, nullptr, 1024, 512, 512, 0, 512);
    setjob(7, mw_o, Wmo, nullptr, 512, 1024, 1024, 0, 0);
    setjob(8, w_gate, Wgu, nullptr, 1024, DFF, DFF, 1, 0);
    setjob(9, w_up, Wgu, nullptr, 1024, DFF, DFF, 1, 4);
    setjob(10, w_down, Wdn, nullptr, DFF, 1024, 1024, 0, 0);
    hipLaunchKernelGGL(k_weights, dim3(1024), dim3(256), 0, stream, jobs);
    hipLaunchKernelGGL(k_rope, dim3((M * 24 + 255) / 256), dim3(256), 0, stream, pos, rope);
    hipLaunchKernelGGL(k_rmsnorm_rows, dim3(2048), dim3(256), 0, stream, x, norm_mix, xn, M);
    hipLaunchKernelGGL(k_rmsnorm_rows, dim3(256), dim3(256), 0, stream, mem, norm_mem_kv, memn, BATCH * NMEM);
    { pg8::EpiStore E{}; E.O = proj; E.ldc = PP; launch_gemm(xn, 1024, Win, 1024, M, PP, 1024, E, stream); }
    { pg8::EpiStore E{}; E.O = kvc; E.ldc = 1024; launch_gemm(memn, 1024, Wmkv, 1024, BATCH * NMEM, 1024, 1024, E, stream); }
    { Post1Args a{}; a.proj = proj; a.kvd = kvd; a.ki = ki; a.wi = wi; a.rope = rope; a.g_dq = g_dq; a.g_dk = g_dk; a.g_ik = g_ik; hipLaunchKernelGGL(k_post1, dim3(2048), dim3(256), 0, stream, a); }
    hipLaunchKernelGGL(k_headnorm128, dim3(256), dim3(256), 0, stream, kvc, BATCH * NMEM, 1024, 0, 4, g_ck, 1.0f);
    hipLaunchKernelGGL(k_index_naive, dim3(M), dim3(256), 0, stream, (const bf16_t*)proj, (const bf16_t*)ki, (const float*)wi, sel);
    { pg8::EpiStore E{}; E.O = qm; E.ldc = 768; launch_gemm(proj + C_CQ, PP, Wuq, 256, M, 768, 256, E, stream); }
    { pg8::EpiStore E{}; E.O = kvm; E.ldc = 1024; launch_gemm(proj + C_CKV, PP, Wukv, 128, M, 1024, 128, E, stream); }
    { Post2Args a{}; a.qm = qm; a.kvm = kvm; a.proj = proj; a.km = km; a.rope = rope; a.g_q = g_mq; a.g_k = g_mk; hipLaunchKernelGGL(k_post2, dim3(2048), dim3(256), 0, stream, a); }
    { AttnArgs a{}; a.Q = qm; a.K = km; a.V = kvm + 64; a.O = mix; a.sel = nullptr; a.q_pitch = 768; a.q_hs = 96; a.k_pitch = 768; a.k_hs = 96; a.v_pitch = 1024; a.v_hs = 128; a.o_pitch = 1024; a.o_hs = 64; a.H = 8; a.kv_group = 1; a.mode = 0; a.n_mem = 0;
      hipLaunchKernelGGL((k_attn_naive<96, 64>), dim3(M * 8 / 4), dim3(256), 0, stream, a); }
    { AttnArgs a{}; a.Q = proj + C_QD; a.K = kvd; a.V = kvd + 128; a.O = mix + 512; a.sel = sel; a.q_pitch = PP; a.q_hs = 64; a.k_pitch = 256; a.k_hs = 64; a.v_pitch = 256; a.v_hs = 64; a.o_pitch = 1024; a.o_hs = 64; a.H = 8; a.kv_group = 4; a.mode = 2; a.n_mem = 0;
      hipLaunchKernelGGL((k_attn_naive<64, 64>), dim3(M * 8 / 4), dim3(256), 0, stream, a); }
    { pg8::EpiResF32 E{}; E.base = x; E.out = out; E.ldc = 1024; launch_gemm(mix, 1024, Wout, 1024, M, 1024, 1024, E, stream); }
    hipLaunchKernelGGL(k_rmsnorm_rows, dim3(2048), dim3(256), 0, stream, (const float*)out, norm_mem_x, xn, M);
    { pg8::EpiStore E{}; E.O = qc; E.ldc = 512; launch_gemm(xn, 1024, Wmq, 1024, M, 512, 1024, E, stream); }
    hipLaunchKernelGGL(k_headnorm128, dim3(2048), dim3(256), 0, stream, qc, M, 512, 0, 4, g_cq, SC_MEM);
    { AttnArgs a{}; a.Q = qc; a.K = kvc; a.V = kvc + 512; a.O = qc; a.sel = nullptr; a.q_pitch = 512; a.q_hs = 128; a.k_pitch = 1024; a.k_hs = 128; a.v_pitch = 1024; a.v_hs = 128; a.o_pitch = 512; a.o_hs = 128; a.H = 4; a.kv_group = 1; a.mode = 1; a.n_mem = NMEM;
      hipLaunchKernelGGL((k_attn_naive<128, 128>), dim3(M * 4 / 4), dim3(256), 0, stream, a); }
    { pg8::EpiResF32 E{}; E.base = out; E.out = out; E.ldc = 1024; launch_gemm(qc, 512, Wmo, 512, M, 1024, 512, E, stream); }
    hipLaunchKernelGGL(k_rmsnorm_rows, dim3(2048), dim3(256), 0, stream, (const float*)out, norm_ffn, xn, M);
    { pg8::EpiSwiGLU E{}; E.H = hb; E.ldh = DFF; launch_gemm(xn, 1024, Wgu, 1024, M, 2 * DFF, 1024, E, stream); }
    { pg8::EpiResF32 E{}; E.base = out; E.out = out; E.ldc = 1024; launch_gemm(hb, DFF, Wdn, DFF, M, 1024, DFF, E, stream); }
}
```

```cpp
#include <hip/hip_runtime.h>
#include <cstdio>
#include <cstdint>
#include <cmath>
__device__ __forceinline__ int tid_opaque() { int t = threadIdx.x; asm volatile("" : "+v"(t)); return t; }
namespace pg8 {
#define PG8_LAS __attribute__((address_space(3)))
typedef unsigned short bf16_t;
typedef short bf16x8 __attribute__((ext_vector_type(8)));
typedef float f32x4 __attribute__((ext_vector_type(4)));
typedef unsigned u32x4 __attribute__((ext_vector_type(4)));
constexpr int BM = 256, BK = 64, HALF = 128, HTB = HALF * BK * 2  , STAGE_BYTES = 8 * HTB, NXCD = 8, WGM = 4;

__host__ __device__ __forceinline__ int lds_byte(int r, int c) { const int st = (r >> 4) * 2 + (c >> 5), rr = r & 15, cc = c & 31, ob = rr * 64 + cc * 2; return st * 1024 + (ob ^ (((ob >> 9) & 1) << 5)); }
__host__ __device__ __forceinline__ void stage_rc(int b, int& R, int& C) { const int st = b / 1024, sb = b % 1024, swz = sb ^ (((sb >> 9) & 1) << 5); R = (st >> 1) * 16 + swz / 64; C = (st & 1) * 32 + (swz % 64) / 2; }
__host__ __device__ __forceinline__ int perm32(int rho) { const int n = rho >> 4, i = rho & 15; return 8 * (i >> 2) + 4 * n + (i & 3); }

struct Unit { int pm, pn; };
struct Gemm { const bf16_t* A; const bf16_t* Bt; int M, N, K, lda, ldb, pad; };

struct StaticOrder {
    int nM, nN, nwg, G, c;
    __host__ __device__ void init(int M, int N, int G_, int c_) { nM = M / BM; nN = N / BM; nwg = nM * nN; G = G_; c = c_; }
    __host__ __device__ bool next(int i, Unit& u) const {
        const long L = (long)i * G + c; if (L >= nwg) return false;
        int wgid = (int)L; { const int q = nwg / NXCD, r = nwg % NXCD, xcd = wgid % NXCD, off = wgid / NXCD; wgid = (xcd < r ? xcd * (q + 1) : r * (q + 1) + (xcd - r) * q) + off; }
        const int nig = WGM * nN, gid = wgid / nig, fm = gid * WGM, gsz = (nM - fm) < WGM ? (nM - fm) : WGM;
        u.pm = fm + ((wgid % nig) % gsz); u.pn = (wgid % nig) / gsz; return true;
    }
    __device__ __forceinline__ void a_ready(const Unit&) const {}
    __device__ __forceinline__ void done(const Unit&) const {}
};

__device__ __forceinline__ unsigned cvt_pk_bf16(float lo, float hi) { unsigned r; asm volatile("v_cvt_pk_bf16_f32 %0, %1, %2" : "=v"(r) : "v"(lo), "v"(hi)); return r; }
struct EpiStore {
    static constexpr bool PERM = true, AFTER_DRAIN = false;
    bf16_t* O; int ldc; int pad;
    __device__ __forceinline__ void operator()(const f32x4 (&acc)[2][2][4][2], const Unit& u, int wr, int wc, int fr, int fq) const {
        const int row0 = u.pm * BM + wr * 64 + fr, col0 = u.pn * BM + wc * 32 + 8 * fq;
#pragma unroll
        for (int ai = 0; ai < 2; ++ai)
#pragma unroll
            for (int m = 0; m < 4; ++m) { bf16_t* rowp = O + (size_t)(row0 + ai * HALF + m * 16) * ldc + col0;
#pragma unroll
                for (int bj = 0; bj < 2; ++bj) { const f32x4 v0 = acc[ai][bj][m][0], v1 = acc[ai][bj][m][1];
                    u32x4 w; w.x = cvt_pk_bf16(v0[0], v0[1]); w.y = cvt_pk_bf16(v0[2], v0[3]); w.z = cvt_pk_bf16(v1[0], v1[1]); w.w = cvt_pk_bf16(v1[2], v1[3]);
                    *(u32x4*)(rowp + bj * HALF) = w; } }
    }
};
struct EpiResF32 {
    static constexpr bool PERM = false, AFTER_DRAIN = false;
    const float* base; float* out; int ldc; int pad;
    __device__ __forceinline__ void operator()(const f32x4 (&acc)[2][2][4][2], const Unit& u, int wr, int wc, int fr, int fq) const {
        const int col0 = u.pn * BM + wc * 32 + 4 * fq;
#pragma unroll
        for (int ai = 0; ai < 2; ++ai)
#pragma unroll
            for (int m = 0; m < 4; ++m) { const size_t off = (size_t)(u.pm * BM + ai * HALF + wr * 64 + m * 16 + fr) * ldc + col0;
#pragma unroll
                for (int bj = 0; bj < 2; ++bj)
#pragma unroll
                    for (int n = 0; n < 2; ++n) { const f32x4 b = *(const f32x4*)(base + off + bj * HALF + n * 16); *(f32x4*)(out + off + bj * HALF + n * 16) = b + acc[ai][bj][m][n]; } }
    }
};
struct EpiResNorm {
    static constexpr bool PERM = false, AFTER_DRAIN = false;
    const float* base; const bf16_t* baseb; bf16_t* xb; float* ssq; int ldc; int pad;
    __device__ __forceinline__ void operator()(const f32x4 (&acc)[2][2][4][2], const Unit& u, int wr, int wc, int fr, int fq) const {
        typedef unsigned u32x2v __attribute__((ext_vector_type(2)));
        const int col0 = u.pn * BM + wc * 32 + 4 * fq; const bool fb = base != nullptr;
#pragma unroll
        for (int ai = 0; ai < 2; ++ai)
#pragma unroll
            for (int m = 0; m < 4; ++m) { const int row = u.pm * BM + ai * HALF + wr * 64 + m * 16 + fr; const size_t off = (size_t)row * ldc + col0; float sq = 0.f;
#pragma unroll
                for (int bj = 0; bj < 2; ++bj)
#pragma unroll
                    for (int n = 0; n < 2; ++n) { f32x4 b;
                        if (fb) b = *(const f32x4*)(base + off + bj * HALF + n * 16);
                        else { const u32x2v w = *(const u32x2v*)(baseb + off + bj * HALF + n * 16); b = (f32x4){__builtin_bit_cast(float, w.x << 16), __builtin_bit_cast(float, w.x & 0xffff0000u), __builtin_bit_cast(float, w.y << 16), __builtin_bit_cast(float, w.y & 0xffff0000u)}; }
                        const f32x4 v = b + acc[ai][bj][m][n];
                        sq += (v[0] * v[0] + v[1] * v[1]) + (v[2] * v[2] + v[3] * v[3]);
                        u32x2v w; w.x = cvt_pk_bf16(v[0], v[1]); w.y = cvt_pk_bf16(v[2], v[3]); *(u32x2v*)(xb + off + bj * HALF + n * 16) = w; }
                sq += __shfl_xor(sq, 16); sq += __shfl_xor(sq, 32);
                if (fq == 0) (void)__builtin_amdgcn_global_atomic_fadd_f32((__attribute__((address_space(1))) float*)(ssq + row), sq); }
    }
};
struct EpiResB16 {
    static constexpr bool PERM = false, AFTER_DRAIN = false;
    const bf16_t* baseb; float* out; int ldc; int pad;
    __device__ __forceinline__ void operator()(const f32x4 (&acc)[2][2][4][2], const Unit& u, int wr, int wc, int fr, int fq) const {
        typedef unsigned u32x2v __attribute__((ext_vector_type(2)));
        const int col0 = u.pn * BM + wc * 32 + 4 * fq;
#pragma unroll
        for (int ai = 0; ai < 2; ++ai)
#pragma unroll
            for (int m = 0; m < 4; ++m) { const size_t off = (size_t)(u.pm * BM + ai * HALF + wr * 64 + m * 16 + fr) * ldc + col0;
#pragma unroll
                for (int bj = 0; bj < 2; ++bj)
#pragma unroll
                    for (int n = 0; n < 2; ++n) { const u32x2v w = *(const u32x2v*)(baseb + off + bj * HALF + n * 16);
                        const f32x4 b = (f32x4){__builtin_bit_cast(float, w.x << 16), __builtin_bit_cast(float, w.x & 0xffff0000u), __builtin_bit_cast(float, w.y << 16), __builtin_bit_cast(float, w.y & 0xffff0000u)};
                        *(f32x4*)(out + off + bj * HALF + n * 16) = b + acc[ai][bj][m][n]; } }
    }
};
struct EpiStoreRS {
    static constexpr bool PERM = true, AFTER_DRAIN = false;
    bf16_t* O; const float* ssq; int ldc; float inv_ncols; float eps; int pad;
    __device__ __forceinline__ void operator()(const f32x4 (&acc)[2][2][4][2], const Unit& u, int wr, int wc, int fr, int fq) const {
        const int row0 = u.pm * BM + wr * 64 + fr, col0 = u.pn * BM + wc * 32 + 8 * fq;
#pragma unroll
        for (int ai = 0; ai < 2; ++ai)
#pragma unroll
            for (int m = 0; m < 4; ++m) { const int row = row0 + ai * HALF + m * 16; bf16_t* rowp = O + (size_t)row * ldc + col0; const float rs = __builtin_amdgcn_rsqf(ssq[row] * inv_ncols + eps);
#pragma unroll
                for (int bj = 0; bj < 2; ++bj) { const f32x4 v0 = acc[ai][bj][m][0] * rs, v1 = acc[ai][bj][m][1] * rs;
                    u32x4 w; w.x = cvt_pk_bf16(v0[0], v0[1]); w.y = cvt_pk_bf16(v0[2], v0[3]); w.z = cvt_pk_bf16(v1[0], v1[1]); w.w = cvt_pk_bf16(v1[2], v1[3]);
                    *(u32x4*)(rowp + bj * HALF) = w; } }
    }
};
struct EpiSwiGLURS {
    static constexpr bool PERM = true, AFTER_DRAIN = false;
    bf16_t* H; const float* ssq; int ldh; float inv_ncols; float eps; int pad;
    __device__ __forceinline__ void operator()(const f32x4 (&acc)[2][2][4][2], const Unit& u, int wr, int wc, int fr, int fq) const {
        typedef unsigned u32x2v __attribute__((ext_vector_type(2)));
        const int row0 = u.pm * BM + wr * 64 + fr, col0 = (u.pn * BM + wc * 32 + 8 * fq) >> 1;
#pragma unroll
        for (int ai = 0; ai < 2; ++ai)
#pragma unroll
            for (int m = 0; m < 4; ++m) { const int row = row0 + ai * HALF + m * 16; bf16_t* rowp = H + (size_t)row * ldh + col0; const float rs = __builtin_amdgcn_rsqf(ssq[row] * inv_ncols + eps);
#pragma unroll
                for (int bj = 0; bj < 2; ++bj) { const f32x4 g = acc[ai][bj][m][0] * rs, up = acc[ai][bj][m][1] * rs; float o[4];
#pragma unroll
                    for (int e = 0; e < 4; ++e) { const float ex = __builtin_amdgcn_exp2f(g[e] * -1.4426950408889634f); o[e] = g[e] * __builtin_amdgcn_rcpf(1.0f + ex) * up[e]; }
                    u32x2v w; w.x = cvt_pk_bf16(o[0], o[1]); w.y = cvt_pk_bf16(o[2], o[3]);
                    *(u32x2v*)(rowp + bj * (HALF / 2)) = w; } }
    }
};
struct EpiSwiGLU {
    static constexpr bool PERM = true, AFTER_DRAIN = false;
    bf16_t* H; int ldh; int pad;
    __device__ __forceinline__ void operator()(const f32x4 (&acc)[2][2][4][2], const Unit& u, int wr, int wc, int fr, int fq) const {
        typedef unsigned u32x2v __attribute__((ext_vector_type(2)));
        const int row0 = u.pm * BM + wr * 64 + fr, col0 = (u.pn * BM + wc * 32 + 8 * fq) >> 1;
#pragma unroll
        for (int ai = 0; ai < 2; ++ai)
#pragma unroll
            for (int m = 0; m < 4; ++m) { bf16_t* rowp = H + (size_t)(row0 + ai * HALF + m * 16) * ldh + col0;
#pragma unroll
                for (int bj = 0; bj < 2; ++bj) { const f32x4 g = acc[ai][bj][m][0], up = acc[ai][bj][m][1]; float o[4];
#pragma unroll
                    for (int e = 0; e < 4; ++e) { const float ex = __builtin_amdgcn_exp2f(g[e] * -1.4426950408889634f); o[e] = g[e] * __builtin_amdgcn_rcpf(1.0f + ex) * up[e]; }
                    u32x2v w; w.x = cvt_pk_bf16(o[0], o[1]); w.y = cvt_pk_bf16(o[2], o[3]);
                    *(u32x2v*)(rowp + bj * (HALF / 2)) = w; } }
    }
};
template <class Epi, class Sched, bool ALIGN_EPI = false, bool SP2 = false>
__device__ __forceinline__ void gemm_phase(PG8_LAS unsigned char* lds, const Gemm g, const Sched& S, const Epi& E) {
    const int tid = tid_opaque(), wid = __builtin_amdgcn_readfirstlane(tid >> 6), lane = tid & 63, wr = wid >> 2, wc = wid & 3, fr = lane & 15, fq = lane >> 4;
    const int K = g.K, nt = K / BK;
    unsigned voffA[2], voffB[2];
#pragma unroll
    for (int i = 0; i < 2; ++i) { int R, C; stage_rc(tid * 16 + i * 8192, R, C); const int Rb = Epi::PERM ? ((R & ~31) + perm32(R & 31)) : R;
        voffA[i] = (unsigned)(R * g.lda + C) * 2u; voffB[i] = (unsigned)(Rb * g.ldb + C) * 2u; }
    const size_t kstep = (size_t)(BK * 2);
    const size_t hstepA = (size_t)HALF * g.lda * 2, hstepB = (size_t)HALF * g.ldb * 2;
    const size_t tstepA = 2 * hstepA, tstepB = 2 * hstepB;
    const unsigned ldsw = (unsigned)wid * 1024u;
    const int aoff = lds_byte(wr * 64 + fr, fq * 8), boff = lds_byte(wc * 32 + fr, fq * 8);
#define PG8_SA(b, h) (((b) * 2 + (h)) * HTB)
#define PG8_SB(b, h) ((4 + (b) * 2 + (h)) * HTB)
#define PG8_STAGE(bufoff, gbase, voff) do { _Pragma("unroll") for (int _i = 0; _i < 2; ++_i) \
        __builtin_amdgcn_global_load_lds((const unsigned*)((const char*)(gbase) + (voff)[_i]), (PG8_LAS unsigned*)(lds + (bufoff) + ldsw + _i * 8192), 16, 0, 0); } while (0)
#define PG8_LDA(dst, b, h) do { _Pragma("unroll") for (int m = 0; m < 4; ++m) _Pragma("unroll") for (int k = 0; k < 2; ++k) dst[m][k] = *(const PG8_LAS bf16x8*)(lds + PG8_SA(b, h) + aoff + m * 2048 + k * 1024); } while (0)
#define PG8_LDB(dst, b, h) do { _Pragma("unroll") for (int n = 0; n < 2; ++n) _Pragma("unroll") for (int k = 0; k < 2; ++k) dst[n][k] = *(const PG8_LAS bf16x8*)(lds + PG8_SB(b, h) + boff + n * 2048 + k * 1024); } while (0)
#define PG8_MMA(ai, bj, At, Bt) do { __builtin_amdgcn_s_setprio(1); _Pragma("unroll") for (int m = 0; m < 4; ++m) _Pragma("unroll") for (int n = 0; n < 2; ++n) _Pragma("unroll") for (int k = 0; k < 2; ++k) \
        acc[ai][bj][m][n] = __builtin_amdgcn_mfma_f32_16x16x32_bf16(Bt[n][k], At[m][k], acc[ai][bj][m][n], 0, 0, 0); __builtin_amdgcn_s_setprio(0); } while (0)
#define PG8_WAIT_V(n) asm volatile("s_waitcnt vmcnt(" #n ")" ::: "memory")
#define PG8_WAIT_L(n) asm volatile("s_waitcnt lgkmcnt(" #n ")" ::: "memory")
#define PG8_BAR __builtin_amdgcn_s_barrier()
#define PG8_SCHED __builtin_amdgcn_sched_barrier(0)
    Unit cur, nxt; int ui = 0;
    if (!S.next(0, cur)) return;
    f32x4 acc[2][2][4][2];
#pragma unroll
    for (int a = 0; a < 2; ++a)
#pragma unroll
        for (int b = 0; b < 2; ++b)
#pragma unroll
            for (int m = 0; m < 4; ++m)
#pragma unroll
                for (int n = 0; n < 2; ++n) acc[a][b][m][n] = (f32x4){0.f, 0.f, 0.f, 0.f};
    bf16x8 At[4][2], B0[2][2], B1[2][2];
    const char* cA = (const char*)g.A + (size_t)cur.pm * tstepA; const char* cB = (const char*)g.Bt + (size_t)cur.pn * tstepB;
    S.a_ready(cur);
    if constexpr (SP2) {
        PG8_STAGE(PG8_SB(0, 0), cB, voffB); PG8_STAGE(PG8_SB(0, 1), cB + hstepB, voffB); PG8_STAGE(PG8_SA(0, 0), cA, voffA); PG8_STAGE(PG8_SA(0, 1), cA + hstepA, voffA);
        if (wr == 1) PG8_BAR;
        PG8_WAIT_V(2); PG8_BAR;
        PG8_STAGE(PG8_SB(1, 0), cB + kstep, voffB); PG8_STAGE(PG8_SA(1, 0), cA + kstep, voffA); PG8_STAGE(PG8_SB(1, 1), cB + hstepB + kstep, voffB);
        PG8_WAIT_V(6); PG8_BAR;
    } else {
        PG8_STAGE(PG8_SB(0, 0), cB, voffB); PG8_STAGE(PG8_SA(0, 0), cA, voffA); PG8_STAGE(PG8_SB(0, 1), cB + hstepB, voffB); PG8_STAGE(PG8_SA(0, 1), cA + hstepA, voffA);
        if (wr == 1) PG8_BAR;
        PG8_WAIT_V(4); PG8_BAR;
        PG8_STAGE(PG8_SB(1, 0), cB + kstep, voffB); PG8_STAGE(PG8_SA(1, 0), cA + kstep, voffA); PG8_STAGE(PG8_SB(1, 1), cB + hstepB + kstep, voffB);
        PG8_WAIT_V(6); PG8_BAR;
    }
    for (;;) {
        const bool has_next = S.next(ui + 1, nxt);
        const char* nA = has_next ? (const char*)g.A + (size_t)nxt.pm * tstepA : cA; const char* nB = has_next ? (const char*)g.Bt + (size_t)nxt.pn * tstepB : cB;
        for (int t = 0; t < nt; t += 2) {
            const bool last = (t == nt - 2);
            const char* a1 = cA + (size_t)(t + 1) * kstep;
            const char* a2 = last ? nA : cA + (size_t)(t + 2) * kstep; const char* b2 = last ? nB : cB + (size_t)(t + 2) * kstep;
            const char* a3 = a2 + kstep; const char* b3 = b2 + kstep;
            if (last && has_next) S.a_ready(nxt);
            if constexpr (SP2) {
            PG8_LDB(B0, 0, 0); PG8_LDB(B1, 0, 1); PG8_SCHED; PG8_LDA(At, 0, 0); PG8_STAGE(PG8_SA(1, 1), a1 + hstepA, voffA);
            PG8_WAIT_V(8); PG8_WAIT_L(0); PG8_BAR; PG8_MMA(0, 0, At, B0); PG8_MMA(0, 1, At, B1); PG8_BAR; PG8_SCHED;
            PG8_LDA(At, 0, 1); PG8_STAGE(PG8_SB(0, 0), b2, voffB); PG8_STAGE(PG8_SB(0, 1), b2 + hstepB, voffB); PG8_STAGE(PG8_SA(0, 0), a2, voffA);
            PG8_WAIT_V(8); PG8_WAIT_L(0); PG8_BAR; PG8_MMA(1, 0, At, B0); PG8_MMA(1, 1, At, B1); PG8_BAR; PG8_SCHED;
            PG8_LDB(B0, 1, 0); PG8_LDB(B1, 1, 1); PG8_SCHED; PG8_LDA(At, 1, 0); PG8_STAGE(PG8_SA(0, 1), a2 + hstepA, voffA);
            PG8_WAIT_V(8); PG8_WAIT_L(0); PG8_BAR; PG8_MMA(0, 0, At, B0); PG8_MMA(0, 1, At, B1); PG8_BAR; PG8_SCHED;
            PG8_LDA(At, 1, 1); PG8_STAGE(PG8_SB(1, 0), b3, voffB); PG8_STAGE(PG8_SB(1, 1), b3 + hstepB, voffB); PG8_STAGE(PG8_SA(1, 0), a3, voffA);
            PG8_WAIT_V(8); PG8_WAIT_L(0); PG8_BAR; PG8_MMA(1, 0, At, B0); PG8_MMA(1, 1, At, B1); PG8_BAR; PG8_SCHED;
            } else {
            PG8_LDB(B0, 0, 0); PG8_SCHED; PG8_LDA(At, 0, 0); PG8_STAGE(PG8_SA(1, 1), a1 + hstepA, voffA);
            PG8_WAIT_L(8); PG8_BAR; PG8_WAIT_L(0); PG8_MMA(0, 0, At, B0); PG8_BAR; PG8_SCHED;
            PG8_LDB(B1, 0, 1); PG8_STAGE(PG8_SB(0, 0), b2, voffB);
            PG8_BAR; PG8_WAIT_L(0); PG8_MMA(0, 1, At, B1); PG8_BAR;
            PG8_LDA(At, 0, 1); PG8_STAGE(PG8_SA(0, 0), a2, voffA);
            PG8_BAR; PG8_WAIT_L(0); PG8_MMA(1, 0, At, B0); PG8_BAR; PG8_SCHED;
            PG8_STAGE(PG8_SB(0, 1), b2 + hstepB, voffB);
            PG8_WAIT_V(6); PG8_BAR; PG8_MMA(1, 1, At, B1); PG8_BAR;
            PG8_LDB(B0, 1, 0); PG8_SCHED; PG8_LDA(At, 1, 0); PG8_STAGE(PG8_SA(0, 1), a2 + hstepA, voffA);
            PG8_WAIT_L(8); PG8_BAR; PG8_WAIT_L(0); PG8_MMA(0, 0, At, B0); PG8_BAR; PG8_SCHED;
            PG8_LDB(B1, 1, 1); PG8_STAGE(PG8_SB(1, 0), b3, voffB);
            PG8_BAR; PG8_WAIT_L(0); PG8_MMA(0, 1, At, B1); PG8_BAR;
            PG8_LDA(At, 1, 1); PG8_STAGE(PG8_SA(1, 0), a3, voffA);
            PG8_BAR; PG8_WAIT_L(0); PG8_MMA(1, 0, At, B0); PG8_BAR; PG8_SCHED;
            PG8_STAGE(PG8_SB(1, 1), b3 + hstepB, voffB);
            PG8_WAIT_V(6); PG8_BAR; PG8_MMA(1, 1, At, B1); PG8_BAR;
            }
        }
        if constexpr (ALIGN_EPI) { if (wr == 0) PG8_BAR; }
        if constexpr (!Epi::AFTER_DRAIN) { E(acc, cur, wr, wc, fr, fq); S.done(cur); }
        if (!has_next) break;
#pragma unroll
        for (int a = 0; a < 2; ++a)
#pragma unroll
            for (int b = 0; b < 2; ++b)
#pragma unroll
                for (int m = 0; m < 4; ++m)
#pragma unroll
                    for (int n = 0; n < 2; ++n) acc[a][b][m][n] = (f32x4){0.f, 0.f, 0.f, 0.f};
        cur = nxt; cA = nA; cB = nB; ++ui;
        if constexpr (ALIGN_EPI) { if (wr == 1) PG8_BAR; }
    }
    PG8_WAIT_V(0);
    if constexpr (!ALIGN_EPI) { if (wr == 0) PG8_BAR; }
    PG8_BAR;
    if constexpr (Epi::AFTER_DRAIN) { E.fused(acc, cur, wr, wc, fr, fq, lds, wid, lane); S.done(cur); }
#undef PG8_SA
#undef PG8_SB
#undef PG8_STAGE
#undef PG8_LDA
#undef PG8_LDB
#undef PG8_MMA
#undef PG8_WAIT_V
#undef PG8_WAIT_L
#undef PG8_BAR
#undef PG8_SCHED
}
}

constexpr int BATCH = 4, SEQ = 8192, DM = 1024, M = BATCH * SEQ, NMEM = 256;
constexpr int PP = 1792;
constexpr int C_CQ = 0, C_CKV = 256, C_KPE = 384, C_QD = 416, C_KD = 928, C_VD = 1056, C_QI = 1184, C_KI = 1696, C_WI = 1760, IN_COLS = 1768;
constexpr int DFF = 2816;
constexpr float EPS = 1e-6f, LOG2E = 1.4426950408889634f;
constexpr float SC_MLA = 0.10206207261596577f * LOG2E;
constexpr float SC_DSA = 0.125f * LOG2E;
constexpr float SC_MEM = 0.08838834764831845f * LOG2E;
constexpr float SC_IDX = 0.125f;
constexpr int ROPE_W = 48;

typedef unsigned short bf16_t;
typedef unsigned u32x4 __attribute__((ext_vector_type(4)));
typedef unsigned u32x2 __attribute__((ext_vector_type(2)));
typedef float f32x4 __attribute__((ext_vector_type(4)));
#define LAS __attribute__((address_space(3)))

constexpr size_t MiB = 1u << 20;
constexpr size_t WS_CTL = 0;
constexpr size_t WS_WIN = 1 * MiB;
constexpr size_t WS_WUQ = WS_WIN + (size_t)PP * 1024 * 2;
constexpr size_t WS_WUKV = WS_WUQ + 768 * 256 * 2;
constexpr size_t WS_WOUT = WS_WUKV + 1024 * 128 * 2;
constexpr size_t WS_WMQ = WS_WOUT + 1024 * 1024 * 2;
constexpr size_t WS_WMKV = WS_WMQ + 512 * 1024 * 2;
constexpr size_t WS_WMO = WS_WMKV + 1024 * 1024 * 2;
constexpr size_t WS_WGU = WS_WMO + 1024 * 512 * 2;
constexpr size_t WS_WDN = WS_WGU + (size_t)5632 * 1024 * 2;
constexpr size_t WS_WEND = WS_WDN + (size_t)1024 * 2816 * 2;
static_assert(WS_WEND <= 29 * MiB, "weights");
constexpr size_t WS_SSQ1 = 28 * MiB, WS_SSQ2 = WS_SSQ1 + (size_t)M * 4, WS_SSQ_CQ = WS_SSQ2 + (size_t)M * 4, WS_SSQ_CKV = WS_SSQ_CQ + (size_t)M * 4, WS_SS_PE = WS_SSQ_CKV + (size_t)M * 4;
static_assert(WS_WEND <= WS_SSQ1 && WS_SS_PE + (size_t)M * 4 <= 29 * MiB, "ssq");
constexpr size_t WS_ROPE = 29 * MiB;
constexpr size_t WS_MEMN = 35 * MiB;
constexpr size_t WS_KVC = 37 * MiB;
constexpr size_t WS_WI = 39 * MiB;
constexpr size_t WS_KI = 40 * MiB;
constexpr size_t WS_KVD = 44 * MiB;
constexpr size_t WS_SEL = 60 * MiB;
constexpr size_t WS_XN = 76 * MiB;
constexpr size_t WS_MIX = 140 * MiB;
constexpr size_t WS_QC = WS_MIX;
constexpr size_t WS_PROJ = 204 * MiB;
constexpr size_t WS_QM = 316 * MiB;
constexpr size_t WS_KVM = 364 * MiB;
constexpr size_t WS_KM = 428 * MiB;
constexpr size_t WS_H = 204 * MiB;
constexpr size_t WS_END = 476 * MiB;
static_assert(WS_H + (size_t)M * DFF * 2 <= WS_KM, "H overlay");

__device__ __forceinline__ unsigned f2bf(float f) { unsigned u = __builtin_bit_cast(unsigned, f); return (u + 0x7fffu + ((u >> 16) & 1u)) >> 16; }
__device__ __forceinline__ unsigned pk2(float lo, float hi) { return f2bf(lo) | (f2bf(hi) << 16); }
__device__ __forceinline__ float bf2f(unsigned short h) { return __builtin_bit_cast(float, (unsigned)h << 16); }
__device__ __forceinline__ float bflo(unsigned w) { return __builtin_bit_cast(float, w << 16); }
__device__ __forceinline__ float bfhi(unsigned w) { return __builtin_bit_cast(float, w & 0xffff0000u); }
__device__ __forceinline__ float wave_sum(float v) {
#pragma unroll
    for (int o = 1; o < 64; o <<= 1) v += __shfl_xor(v, o);
    return v;
}
__device__ __forceinline__ float wave_max(float v) {
#pragma unroll
    for (int o = 1; o < 64; o <<= 1) v = fmaxf(v, __shfl_xor(v, o));
    return v;
}


#define XB_TMO      128
#define XB_XCNT(j)  (256  + 64 * (j))
#define XB_XSUB(j)  (1280 + 64 * (j))
#define XB_XGEN(j)  (2304 + 64 * (j))
#define XB_TOP      3328
#define XB_TOPGEN   3392
#define XCD_BAR_WORDS 3456
#define XB_SPIN_CAP (1u << 24)

__device__ __forceinline__ unsigned xb_ld(unsigned* p)              { return __hip_atomic_load(p, __ATOMIC_RELAXED, __HIP_MEMORY_SCOPE_AGENT); }
__device__ __forceinline__ unsigned xb_add(unsigned* p, unsigned v) { return __hip_atomic_fetch_add(p, v, __ATOMIC_RELAXED, __HIP_MEMORY_SCOPE_AGENT); }
__device__ __forceinline__ unsigned xb_xcc_id() { return (unsigned)__builtin_amdgcn_s_getreg((3 << 11) | 20) & 0xFu; }
#define XB_SPIN(cond, bar) do { unsigned _sp = 0; while (cond) { __builtin_amdgcn_s_sleep(1); \
    if ((++_sp & 255u) == 0u) { if (xb_ld(&(bar)[XB_TMO])) break; if (_sp > XB_SPIN_CAP) { atomicAdd(&(bar)[XB_TMO], 1u); break; } } } } while (0)

struct XcdBarrier {
    unsigned* bar; unsigned x;
    volatile LAS unsigned* st;
};

__device__ __forceinline__ XcdBarrier xcd_barrier_post(unsigned* bar, volatile LAS unsigned* st) {
    XcdBarrier b; b.bar = bar; b.x = xb_xcc_id(); b.st = st;
    if (threadIdx.x == 0) (void)xb_add(&bar[XB_XCNT(b.x)], 1u);
    return b;
}
__device__ __forceinline__ void xcd_barrier_complete(unsigned* bar, unsigned x, unsigned& nloc, unsigned& nx) {
    const unsigned G = gridDim.x * gridDim.y * gridDim.z;
    unsigned sum, cnt, mine, sp = 0u;
    for (;;) {
        sum = 0u; cnt = 0u; mine = 0u;
#pragma unroll
        for (unsigned j = 0; j < 16; ++j) { const unsigned c = xb_ld(&bar[XB_XCNT(j)]); sum += c; cnt += (c > 0u) ? 1u : 0u; mine = (j == x) ? c : mine; }
        if (sum == G) break;
        __builtin_amdgcn_s_sleep(1);
        if ((++sp & 255u) == 0u) { if (xb_ld(&bar[XB_TMO])) break; if (sp > XB_SPIN_CAP) { atomicAdd(&bar[XB_TMO], 1u); break; } }
    }
    nloc = mine > 0u ? mine : 1u; nx = cnt > 0u ? cnt : 1u;
}

__device__ __forceinline__ void xcd_barrier(const XcdBarrier& b) {
    asm volatile("s_waitcnt vmcnt(0)" ::: "memory");
    __syncthreads();
    if (threadIdx.x == 0) {
        unsigned* bar = b.bar;
        __builtin_amdgcn_s_waitcnt(0);
        unsigned nloc = b.st[0], nx = b.st[1];
        if (nloc == 0u) { xcd_barrier_complete(bar, b.x, nloc, nx); b.st[0] = nloc; b.st[1] = nx; }
        const unsigned old = xb_add(&bar[XB_XSUB(b.x)], 1u);
        const unsigned gen = old / nloc;
        if (old + 1u == (gen + 1u) * nloc) {
            __builtin_amdgcn_fence(__ATOMIC_RELEASE, "agent");
            asm volatile("s_waitcnt vmcnt(0)" ::: "memory");
            const unsigned og = xb_add(&bar[XB_TOP], 1u);
            const unsigned tg = og / nx;
            if (og + 1u == (tg + 1u) * nx) xb_add(&bar[XB_TOPGEN], 1u);
            else XB_SPIN(xb_ld(&bar[XB_TOPGEN]) == tg, bar);
            __builtin_amdgcn_fence(__ATOMIC_ACQUIRE, "agent");
            xb_add(&bar[XB_XGEN(b.x)], 1u);
            asm volatile("s_waitcnt vmcnt(0)" ::: "memory");
        } else {
            XB_SPIN(xb_ld(&bar[XB_XGEN(b.x)]) == gen, bar);
            __builtin_amdgcn_fence(__ATOMIC_ACQUIRE, "agent");
            asm volatile("s_waitcnt vmcnt(0)" ::: "memory");
        }
    }
    __syncthreads();
}


constexpr int NWAVES = 8, NTHREADS = 512;
constexpr int RING_BYTES = 131072;
constexpr int MISC_OFF = RING_BYTES + 320;
constexpr int LDS_BYTES = 147456;
constexpr int CW_BAR = 4096;
constexpr size_t CTL_ZERO_BYTES = 64 * 1024;

struct Params { const float* in[27]; float* out; unsigned char* ws; };
typedef const unsigned long long volatile __attribute__((address_space(4))) * karg_ptr_t;
#define AS_GLOBAL(T, bits) ((T)(__attribute__((address_space(1))) void*)(bits))
__device__ __forceinline__ const void* karg(int i) { return AS_GLOBAL(const void*, ((karg_ptr_t)__builtin_amdgcn_kernarg_segment_ptr())[i]); }
#define P_IN(k) ((const float*)karg(k))
#define P_OUT ((float*)karg(27))
#define P_WS ((unsigned char*)karg(28))

__device__ __forceinline__ int proj_pi_inv(int d) { return d < 8 ? 8 * (d >> 1) + (d & 1) : d < 16 ? 8 * ((d - 8) >> 1) + 2 + ((d - 8) & 1) : d < 32 ? 8 * ((d - 16) >> 2) + 4 + ((d - 16) & 3) : d; }
__device__ __forceinline__ int proj_dst_row(int c) {
    int T, wc, j;
    if (c < C_CKV) { T = 0; wc = c >> 6; j = c & 63; }
    else if (c < C_KPE) { T = 1; wc = (c - C_CKV) >> 6; j = (c - C_CKV) & 63; }
    else if (c < C_QD) { T = 1; wc = 2; j = c - C_KPE; }
    else if (c < C_KD) { const int h = (c - C_QD) >> 6; T = 2 + (h >> 2); wc = h & 3; j = proj_pi_inv((c - C_QD) & 63); }
    else if (c < C_VD) { T = 6; wc = (c - C_KD) >> 6; j = proj_pi_inv((c - C_KD) & 63); }
    else if (c < C_QI) { T = 6; wc = 2 + ((c - C_VD) >> 6); j = (c - C_VD) & 63; }
    else if (c < C_KI) { const int h = (c - C_QI) >> 6; T = 4 + (h >> 2); wc = h & 3; j = proj_pi_inv((c - C_QI) & 63); }
    else if (c < C_WI) { T = 1; wc = 3; j = proj_pi_inv(c - C_KI); }
    else { T = 1; wc = 2; j = 32 + (c - C_WI); }
    return 256 * T + (j < 32 ? 32 * wc + j : 128 + 32 * wc + (j - 32));
}
__device__ __forceinline__ int kvm_dst_row(int c) { const int h = c >> 7, isv = (c >> 6) & 1, d = c & 63, wc = 2 * (h & 1) + isv; return 256 * (h >> 1) + (d < 32 ? 32 * wc + d : 128 + 32 * wc + (d - 32)); }
__device__ __forceinline__ int wt_dst_row(int c, int mode, int row_off) { return mode == 0 ? row_off + c : (mode == 1 ? ((c >> 2) * 8 + (c & 3) + row_off) : (mode == 2 ? proj_dst_row(c) : kvm_dst_row(c))); }
__device__ __forceinline__ void transpose_item(const float* W, int K, int Nsrc, bf16_t* WT, int mode, int row_off, const float* gk, LAS float* scr, int kb, int nb, int lane) {
    const int k0 = 64 * kb, n0 = 32 * nb;
    const int c = n0 + (lane & 31); const bool inb = c < Nsrc;
    const float* wp = W + (size_t)(k0 + (lane >> 5)) * Nsrc + (inb ? c : 0);
    float v[32];
#pragma unroll
    for (int i = 0; i < 32; ++i) v[i] = wp[(size_t)(2 * i) * Nsrc];
    if (gk) {
#pragma unroll
        for (int i = 0; i < 32; ++i) v[i] *= gk[k0 + 2 * i + (lane >> 5)];
    }
#pragma unroll
    for (int i = 0; i < 32; ++i) scr[(2 * i + (lane >> 5)) * 33 + (lane & 31)] = inb ? v[i] : 0.f;
    asm volatile("s_waitcnt lgkmcnt(0)" ::: "memory");
    const int ch = lane & 7;
#pragma unroll
    for (int j = 0; j < 4; ++j) { const int n = (lane >> 3) + 8 * j; const LAS float* s = scr + (8 * ch) * 33 + n;
        u32x4 o; o.x = pk2(s[0 * 33], s[1 * 33]); o.y = pk2(s[2 * 33], s[3 * 33]); o.z = pk2(s[4 * 33], s[5 * 33]); o.w = pk2(s[6 * 33], s[7 * 33]);
        *(u32x4*)(WT + (size_t)wt_dst_row(n0 + n, mode, row_off) * K + k0 + 8 * ch) = o; }
    asm volatile("s_waitcnt lgkmcnt(0)" ::: "memory");
}
struct WtJob { const float* W; bf16_t* WT; const float* gk; int K, Nsrc, Ncover, mode, row_off; };
constexpr int N_WT_JOBS = 11;
__device__ __forceinline__ WtJob wt_job(int i) {
    unsigned char* ws = P_WS; WtJob j;
    switch (i) {
        case 0:  j = WtJob{P_IN(4),  (bf16_t*)(ws + WS_WIN),  nullptr,  1024, IN_COLS, PP,   2, 0};   break;
        case 1:  j = WtJob{P_IN(6),  (bf16_t*)(ws + WS_WUQ),  P_IN(5),  256,  768,     768,  0, 0};   break;
        case 2:  j = WtJob{P_IN(8),  (bf16_t*)(ws + WS_WUKV), P_IN(7),  128,  1024,    1024, 3, 0};   break;
        case 3:  j = WtJob{P_IN(14), (bf16_t*)(ws + WS_WOUT), nullptr,  1024, 1024,    1024, 0, 0};   break;
        case 4:  j = WtJob{P_IN(17), (bf16_t*)(ws + WS_WMQ),  P_IN(15), 1024, 512,     512,  0, 0};   break;
        case 5:  j = WtJob{P_IN(18), (bf16_t*)(ws + WS_WMKV), nullptr,  1024, 512,     512,  0, 0};   break;
        case 6:  j = WtJob{P_IN(19), (bf16_t*)(ws + WS_WMKV), nullptr,  1024, 512,     512,  0, 512}; break;
        case 7:  j = WtJob{P_IN(22), (bf16_t*)(ws + WS_WMO),  nullptr,  512,  1024,    1024, 0, 0};   break;
        case 8:  j = WtJob{P_IN(24), (bf16_t*)(ws + WS_WGU),  P_IN(23), 1024, DFF,     DFF,  1, 0};   break;
        case 9:  j = WtJob{P_IN(25), (bf16_t*)(ws + WS_WGU),  P_IN(23), 1024, DFF,     DFF,  1, 4};   break;
        default: j = WtJob{P_IN(26), (bf16_t*)(ws + WS_WDN),  nullptr,  DFF,  1024,    1024, 0, 0};   break;
    }
    return j;
}
__device__ __forceinline__ void ph_weights(LAS unsigned char* L, int gw, int NGW, int wave, int lane, bool early) {
    LAS float* scr = (LAS float*)(L + wave * 16384);
    int base = 0;
    for (int ji = 0; ji < N_WT_JOBS; ++ji) {
        if (((ji == 0) || (ji == 5) || (ji == 6)) != early) continue;
        const WtJob jb = wt_job(ji);
        const int nnb = jb.Ncover / 32, nitems = (jb.K / 64) * nnb;
        int first = (gw - base % NGW + NGW) % NGW;
        for (int it = first; it < nitems; it += NGW) transpose_item(jb.W, jb.K, jb.Nsrc, jb.WT, jb.mode, jb.row_off, jb.gk, scr, it / nnb, it % nnb, lane);
        base += nitems;
    }
}
__device__ __forceinline__ void rms_row_1024(const float* xrow, const float* g, bf16_t* orow, int lane) {
    const f32x4* xr = (const f32x4*)xrow + lane; const f32x4* gr = (const f32x4*)g + lane;
    f32x4 v[4]; float s = 0.f;
#pragma unroll
    for (int j = 0; j < 4; ++j) { v[j] = xr[64 * j]; s += (v[j].x * v[j].x + v[j].y * v[j].y) + (v[j].z * v[j].z + v[j].w * v[j].w); }
    const float rstd = 1.0f / sqrtf(wave_sum(s) * (1.f / 1024.f) + EPS);
    unsigned long long* o8 = (unsigned long long*)orow + lane;
#pragma unroll
    for (int j = 0; j < 4; ++j) { const f32x4 gg = gr[64 * j]; o8[64 * j] = (unsigned long long)pk2(v[j].x * rstd * gg.x, v[j].y * rstd * gg.y) | ((unsigned long long)pk2(v[j].z * rstd * gg.z, v[j].w * rstd * gg.w) << 32); }
}
__device__ __forceinline__ void ph_rmsnorm_rows(const float* X, const float* g, bf16_t* O, int R, int gw, int NGW, int lane) {
    const f32x4* gr = (const f32x4*)g + lane;
    for (int r0 = gw * 4; r0 < R; r0 += NGW * 4) {
        f32x4 v[4][4];
#pragma unroll
        for (int q = 0; q < 4; ++q) { const f32x4* xr = (const f32x4*)(X + (size_t)(r0 + q) * 1024) + lane;
#pragma unroll
            for (int j = 0; j < 4; ++j) v[q][j] = xr[64 * j]; }
#pragma unroll
        for (int q = 0; q < 4; ++q) { float s = 0.f;
#pragma unroll
            for (int j = 0; j < 4; ++j) s += (v[q][j].x * v[q][j].x + v[q][j].y * v[q][j].y) + (v[q][j].z * v[q][j].z + v[q][j].w * v[q][j].w);
            const float rstd = 1.0f / sqrtf(wave_sum(s) * (1.f / 1024.f) + EPS);
            unsigned long long* o8 = (unsigned long long*)(O + (size_t)(r0 + q) * 1024) + lane;
#pragma unroll
            for (int j = 0; j < 4; ++j) { const f32x4 gg = gr[64 * j]; o8[64 * j] = (unsigned long long)pk2(v[q][j].x * rstd * gg.x, v[q][j].y * rstd * gg.y) | ((unsigned long long)pk2(v[q][j].z * rstd * gg.z, v[q][j].w * rstd * gg.w) << 32); } }
    }
}
__device__ __forceinline__ void ph_rope(const int* pos, float* tab, int gtid, int NGT) {
    for (int i = gtid; i < M * 24; i += NGT) {
        const int tok = i / 24, j = i % 24;
        const float e = (j < 16) ? (float)j * (1.0f / 16.0f) : (float)(j - 16) * (1.0f / 8.0f);
        const float inv = exp2f(-e * 18.931568569324174f);
        const float ang = (float)pos[tok] * inv;
        const double rev = (double)ang * 0.15915494309189535; const float fr = (float)(rev - rint(rev));
        const float c = __builtin_amdgcn_cosf(fr), s = __builtin_amdgcn_sinf(fr);
        float* t = tab + (size_t)tok * ROPE_W;
        if (j < 16) { t[j] = c; t[16 + j] = s; } else { t[32 + (j - 16)] = c; t[40 + (j - 16)] = s; }
    }
}

struct Post1Args { bf16_t* proj; bf16_t* kvd; bf16_t* ki; float* wi; const float* rope; const float* g_dq; const float* g_dk; const float* g_ik; bf16_t* pout; };
__device__ __forceinline__ void unpack8(const u32x4 w, float (&v)[8]) { v[0] = bflo(w.x); v[1] = bfhi(w.x); v[2] = bflo(w.y); v[3] = bfhi(w.y); v[4] = bflo(w.z); v[5] = bfhi(w.z); v[6] = bflo(w.w); v[7] = bfhi(w.w); }
__device__ __forceinline__ u32x4 pack8(const float (&v)[8]) { u32x4 w; w.x = pk2(v[0], v[1]); w.y = pk2(v[2], v[3]); w.z = pk2(v[4], v[5]); w.w = pk2(v[6], v[7]); return w; }
__device__ __forceinline__ void ph_post1(const Post1Args& a, LAS unsigned char* L, int gw, int NGW, int wave, int lane) {
    (void)L; (void)wave;
    const int sub = lane & 7;
    const int offA = lane < 32 ? C_CQ + 8 * lane : (lane < 48 ? C_CKV + 8 * (lane - 32) : -1);
    const int offD = lane < 16 ? C_KD + 8 * lane : (lane < 24 ? C_KI + 8 * (lane - 16) : (lane >= 32 && lane < 48 ? C_VD + 8 * (lane - 32) : (lane == 48 ? C_WI : -1)));
    float gB[8], gD[8];
#pragma unroll
    for (int e = 0; e < 8; ++e) { gB[e] = a.g_dq[sub * 8 + e]; gD[e] = lane < 16 ? a.g_dk[sub * 8 + e] : (lane < 24 ? a.g_ik[sub * 8 + e] : 1.f); }
    u32x4 nA, nB, nC, nD; f32x4 nr[4];
#define P1_LOAD(tk) do { const bf16_t* pr_ = a.proj + (size_t)(tk) * PP; const f32x4* rt_ = (const f32x4*)(a.rope + (size_t)(tk) * ROPE_W + 32); \
        nA = (u32x4){0u, 0u, 0u, 0u}; nD = nA; if (offA >= 0) nA = *(const u32x4*)(pr_ + offA); nB = *(const u32x4*)(pr_ + C_QD + 8 * lane); nC = *(const u32x4*)(pr_ + C_QI + 8 * lane); \
        if (offD >= 0) nD = *(const u32x4*)(pr_ + offD); nr[0] = rt_[0]; nr[1] = rt_[1]; nr[2] = rt_[2]; nr[3] = rt_[3]; } while (0)
    if (gw < M) P1_LOAD(gw);
    for (int tok = gw; tok < M; tok += NGW) {
        const u32x4 cA = nA, cB = nB, cC = nC, cD = nD; const float cp[8] = {nr[0].x, nr[0].y, nr[0].z, nr[0].w, nr[1].x, nr[1].y, nr[1].z, nr[1].w}, sp[8] = {nr[2].x, nr[2].y, nr[2].z, nr[2].w, nr[3].x, nr[3].y, nr[3].z, nr[3].w};
        if (tok + NGW < M) P1_LOAD(tok + NGW);
        bf16_t* po = a.pout + (size_t)tok * PP;
        float v[8];
        { unpack8(cA, v); float s = 0.f;
#pragma unroll
          for (int e = 0; e < 8; ++e) s += v[e] * v[e];
          s += __shfl_xor(s, 1); s += __shfl_xor(s, 2); s += __shfl_xor(s, 4); s += __shfl_xor(s, 8);
          { const float t16 = __shfl_xor(s, 16); if (lane < 32) s += t16; }
          const float r = __builtin_amdgcn_rsqf(s * (lane < 32 ? 1.f / 256.f : 1.f / 128.f) + EPS);
#pragma unroll
          for (int e = 0; e < 8; ++e) v[e] *= r;
          if (offA >= 0) *(u32x4*)(po + offA) = pack8(v); }
#pragma unroll
        for (int pass = 0; pass < 2; ++pass) { unpack8(pass == 0 ? cB : cC, v);
            if (pass == 0) { float s = 0.f;
#pragma unroll
                for (int e = 0; e < 8; ++e) s += v[e] * v[e];
                s += __shfl_xor(s, 1); s += __shfl_xor(s, 2); s += __shfl_xor(s, 4);
                const float r = __builtin_amdgcn_rsqf(s * (1.f / 64.f) + EPS);
#pragma unroll
                for (int e = 0; e < 8; ++e) v[e] *= r * gB[e]; }
#pragma unroll
            for (int e = 0; e < 8; ++e) { const float o = __shfl_xor(v[e], 1); if (sub == 0) v[e] = v[e] * cp[e] - o * sp[e]; else if (sub == 1) v[e] = v[e] * cp[e] + o * sp[e]; }
            const float sc = pass == 0 ? SC_DSA : SC_IDX;
#pragma unroll
            for (int e = 0; e < 8; ++e) v[e] *= sc;
            *(u32x4*)(po + (pass == 0 ? C_QD : C_QI) + 8 * lane) = pack8(v); }
        { unpack8(cD, v); float s = 0.f;
#pragma unroll
          for (int e = 0; e < 8; ++e) s += v[e] * v[e];
          s += __shfl_xor(s, 1); s += __shfl_xor(s, 2); s += __shfl_xor(s, 4);
          const float r = lane < 24 ? __builtin_amdgcn_rsqf(s * (1.f / 64.f) + EPS) : 1.f;
          float u[8];
#pragma unroll
          for (int e = 0; e < 8; ++e) u[e] = v[e] * r * gD[e];
#pragma unroll
          for (int e = 0; e < 8; ++e) { const float o = __shfl_xor(u[e], 1); if (lane < 24) { if (sub == 0) u[e] = u[e] * cp[e] - o * sp[e]; else if (sub == 1) u[e] = u[e] * cp[e] + o * sp[e]; } }
          if (lane < 16) *(u32x4*)(a.kvd + (size_t)tok * 256 + 8 * lane) = pack8(u);
          else if (lane < 24) *(u32x4*)(a.ki + (size_t)tok * 64 + 8 * (lane - 16)) = pack8(u);
          else if (lane >= 32 && lane < 48) *(u32x4*)(a.kvd + (size_t)tok * 256 + 128 + 8 * (lane - 32)) = cD;
          else if (lane == 48) { float* wp = a.wi + (size_t)tok * 8; *(f32x4*)wp = (f32x4){v[0], v[1], v[2], v[3]} * 0.35355339059327373f; *(f32x4*)(wp + 4) = (f32x4){v[4], v[5], v[6], v[7]} * 0.35355339059327373f; } }
    }
#undef P1_LOAD
}
struct Post2Args { bf16_t* qm; const bf16_t* kvm; const bf16_t* proj; bf16_t* km; const float* rope; const float* g_q; const float* g_k; bf16_t* qout; };
template <bool DO_Q> __device__ __forceinline__ void ph_post2(const Post2Args& a, LAS unsigned char* L, int gw, int NGW, int wave, int lane) {
    (void)L; (void)wave;
    const int j = lane & 15, hq = lane >> 4; const bool act = j < 12;
    float gq[8], gk[8];
#pragma unroll
    for (int e = 0; e < 8; ++e) { gq[e] = act ? a.g_q[j * 8 + e] : 0.f; gk[e] = act ? a.g_k[j * 8 + e] : 0.f; }
    u32x4 nq[2], nk[2]; f32x4 nr[4];
#define P2_LOAD(tk) do { const bf16_t* q_ = a.qm + (size_t)(tk) * 768; const bf16_t* kv_ = a.kvm + (size_t)(tk) * 1024; const bf16_t* pe_ = a.proj + (size_t)(tk) * PP + C_KPE; \
        const f32x4* rt_ = (const f32x4*)(a.rope + (size_t)(tk) * ROPE_W + 8 * (j & 1)); \
        _Pragma("unroll") for (int ps = 0; ps < 2; ++ps) { const int h_ = ps * 4 + hq; nq[ps] = (u32x4){0u, 0u, 0u, 0u}; nk[ps] = nq[ps]; \
            if (act) { if (DO_Q) nq[ps] = *(const u32x4*)(q_ + h_ * 96 + 8 * j); nk[ps] = (j < 8) ? *(const u32x4*)(kv_ + 128 * h_ + 8 * j) : *(const u32x4*)(pe_ + 8 * (j - 8)); } } \
        nr[0] = rt_[0]; nr[1] = rt_[1]; nr[2] = rt_[4]; nr[3] = rt_[5]; } while (0)
    if (gw < M) P2_LOAD(gw);
    for (int tok = gw; tok < M; tok += NGW) {
        const u32x4 cq[2] = {nq[0], nq[1]}, ck[2] = {nk[0], nk[1]};
        const float cm[8] = {nr[0].x, nr[0].y, nr[0].z, nr[0].w, nr[1].x, nr[1].y, nr[1].z, nr[1].w}, sm[8] = {nr[2].x, nr[2].y, nr[2].z, nr[2].w, nr[3].x, nr[3].y, nr[3].z, nr[3].w};
        if (tok + NGW < M) P2_LOAD(tok + NGW);
        bf16_t* qrow = a.qout + (size_t)tok * 768; bf16_t* krow = a.km + (size_t)tok * 768;
#pragma unroll
        for (int ps = 0; ps < 2; ++ps) { const int h = ps * 4 + hq;
#pragma unroll
            for (int qk = DO_Q ? 0 : 1; qk < 2; ++qk) { float v[8]; unpack8(qk == 0 ? cq[ps] : ck[ps], v); float s = 0.f;
#pragma unroll
                for (int e = 0; e < 8; ++e) s += v[e] * v[e];
                s += __shfl_xor(s, 1); s += __shfl_xor(s, 2); s += __shfl_xor(s, 4); s += __shfl_xor(s, 8);
                const float r = __builtin_amdgcn_rsqf(s * (1.f / 96.f) + EPS);
#pragma unroll
                for (int e = 0; e < 8; ++e) v[e] *= r * (qk == 0 ? gq[e] : gk[e]);
#pragma unroll
                for (int e = 0; e < 8; ++e) { const float o = __shfl_xor(v[e], 2); if (j >= 8) { if (j < 10) v[e] = v[e] * cm[e] - o * sm[e]; else v[e] = v[e] * cm[e] + o * sm[e]; } }
                if (qk == 0) {
#pragma unroll
                    for (int e = 0; e < 8; ++e) v[e] *= SC_MLA;
                    if (act) *(u32x4*)(qrow + h * 96 + 8 * j) = pack8(v);
                } else if (act) *(u32x4*)(krow + h * 96 + 8 * j) = pack8(v); } }
    }
#undef P2_LOAD
}
__device__ __forceinline__ void ph_headnorm128(bf16_t* X, int R, int pitch, int col0, int nheads, const float* g, float sc, int gw, int NGW, int lane) {
    const int per_row = nheads / 4;
    for (int it = gw; it < R * per_row; it += NGW) {
        const int r = it / per_row, h = (it % per_row) * 4 + (lane >> 4), sub = lane & 15;
        bf16_t* p = X + (size_t)r * pitch + col0 + h * 128 + sub * 8;
        const u32x4 w = *(const u32x4*)p; float v[8] = {bflo(w.x), bfhi(w.x), bflo(w.y), bfhi(w.y), bflo(w.z), bfhi(w.z), bflo(w.w), bfhi(w.w)};
        float s = 0.f;
#pragma unroll
        for (int e = 0; e < 8; ++e) s += v[e] * v[e];
        s += __shfl_xor(s, 1); s += __shfl_xor(s, 2); s += __shfl_xor(s, 4); s += __shfl_xor(s, 8);
        const float rr = sc / sqrtf(s * (1.f / 128.f) + EPS);
#pragma unroll
        for (int e = 0; e < 8; ++e) v[e] *= rr * g[sub * 8 + e];
        u32x4 o; o.x = pk2(v[0], v[1]); o.y = pk2(v[2], v[3]); o.z = pk2(v[4], v[5]); o.w = pk2(v[6], v[7]); *(u32x4*)p = o;
    }
}

struct AttnArgs { const bf16_t* Q; const bf16_t* K; const bf16_t* V; bf16_t* O; const unsigned short* sel;
                  int q_pitch, q_hs, k_pitch, k_hs, v_pitch, v_hs, o_pitch, o_hs, H, kv_group, mode, n_mem; };
template <int DQK, int DV> __device__ __forceinline__ void ph_attn_naive(const AttnArgs& a, LAS unsigned char* L, int gw, int NGW, int wave, int lane) {
    LAS float* qs = (LAS float*)(L + wave * 1024);
    const long total = (long)M * a.H;
    for (long wid = gw; wid < total; wid += NGW) {
        const int row = (int)(wid / a.H), h = (int)(wid % a.H), b = row / SEQ, t = row % SEQ, kvh = h / a.kv_group;
        const bf16_t* q = a.Q + (size_t)row * a.q_pitch + h * a.q_hs;
        __builtin_amdgcn_s_waitcnt(0); __builtin_amdgcn_wave_barrier();
        for (int d = lane; d < DQK; d += 64) qs[d] = bf2f(q[d]);
        __builtin_amdgcn_s_waitcnt(0); __builtin_amdgcn_wave_barrier();
        const int n = a.mode == 0 ? t + 1 : (a.mode == 1 ? a.n_mem : 256);
        const long kbase = a.mode == 1 ? (long)b * a.n_mem : (long)b * SEQ;
        float mrun = -INFINITY, l = 0.f, acc[DV / 64];
#pragma unroll
        for (int i = 0; i < DV / 64; ++i) acc[i] = 0.f;
        for (int c0 = 0; c0 < n; c0 += 64) {
            const int j = c0 + lane; bool valid = j < n; long krow = kbase;
            if (valid) { if (a.mode == 2) { const unsigned idx = a.sel[(size_t)row * 256 + j]; valid = idx != 0xFFFFu && (int)idx <= t; krow = kbase + (valid ? idx : 0); } else krow = kbase + j; }
            float s = -INFINITY;
            if (valid) { const bf16_t* kp = a.K + (size_t)krow * a.k_pitch + kvh * a.k_hs; float d0 = 0.f;
#pragma unroll
                for (int c = 0; c < DQK / 8; ++c) { const u32x4 w = *(const u32x4*)(kp + c * 8); const LAS float* qq = qs + c * 8;
                    d0 += qq[0] * bflo(w.x) + qq[1] * bfhi(w.x) + qq[2] * bflo(w.y) + qq[3] * bfhi(w.y) + qq[4] * bflo(w.z) + qq[5] * bfhi(w.z) + qq[6] * bflo(w.w) + qq[7] * bfhi(w.w); }
                s = d0; }
            const float cmx = wave_max(s);
            if (cmx == -INFINITY) continue;
            const float mnew = fmaxf(mrun, cmx);
            const float alpha = (mrun == -INFINITY) ? 0.f : exp2f(mrun - mnew);
            const float p = valid ? exp2f(s - mnew) : 0.f;
            l = l * alpha + wave_sum(p);
#pragma unroll
            for (int i = 0; i < DV / 64; ++i) acc[i] *= alpha;
            mrun = mnew;
            const int cnt = (n - c0) < 64 ? (n - c0) : 64;
            for (int jj = 0; jj < cnt; ++jj) {
                const float pj = __shfl(p, jj); const long rj = __shfl((int)(krow - kbase), jj) + kbase;
                if (pj != 0.f) { const bf16_t* vp = a.V + (size_t)rj * a.v_pitch + kvh * a.v_hs;
#pragma unroll
                    for (int i = 0; i < DV / 64; ++i) acc[i] += pj * bf2f(vp[lane + 64 * i]); }
            }
        }
        bf16_t* o = a.O + (size_t)row * a.o_pitch + h * a.o_hs;
        const float il = 1.0f / l;
#pragma unroll
        for (int i = 0; i < DV / 64; ++i) o[lane + 64 * i] = (bf16_t)f2bf(acc[i] * il);
    }
}

__device__ __forceinline__ unsigned mono_key(float s) { const unsigned u = __builtin_bit_cast(unsigned, s + 0.0f); return (u & 0x80000000u) ? ~u : (u | 0x80000000u); }
__device__ __forceinline__ void ph_index_naive(const bf16_t* proj, const bf16_t* Ki, const float* Wi, unsigned short* SEL, LAS unsigned char* L, int bid, int G) {
    LAS unsigned* keys = (LAS unsigned*)L;
    LAS float* qs = (LAS float*)(L + 32768);
    LAS float* wsm = (LAS float*)(L + 32768 + 2048);
    LAS int* red = (LAS int*)(L + 32768 + 2048 + 64);
    LAS int* cgt = (LAS int*)(L + 36864);
    LAS int* ceq = cgt + 512;
    const int tid = tid_opaque(), lane = tid & 63, wave = tid >> 6;
    for (int row = bid; row < M; row += G) {
        const int b = row / SEQ, t = row % SEQ, n = t + 1;
        unsigned short* out = SEL + (size_t)row * 256;
        if (n <= 256) { if (tid < 256) out[tid] = tid < n ? (unsigned short)tid : (unsigned short)0xFFFFu; continue; }
        __syncthreads();
        qs[tid] = bf2f(proj[(size_t)row * PP + C_QI + tid]);
        if (tid < 8) wsm[tid] = Wi[(size_t)row * 8 + tid];
        __syncthreads();
        for (int j = tid; j < n; j += NTHREADS) {
            const bf16_t* kp = Ki + ((size_t)b * SEQ + j) * 64; float d[8];
#pragma unroll
            for (int h = 0; h < 8; ++h) d[h] = 0.f;
#pragma unroll 1
            for (int c = 0; c < 8; ++c) { const u32x4 w = *(const u32x4*)(kp + c * 8);
                const float k0 = bflo(w.x), k1 = bfhi(w.x), k2 = bflo(w.y), k3 = bfhi(w.y), k4 = bflo(w.z), k5 = bfhi(w.z), k6 = bflo(w.w), k7 = bfhi(w.w);
#pragma unroll
                for (int h = 0; h < 8; ++h) { const LAS float* qq = qs + h * 64 + c * 8;
                    d[h] += qq[0] * k0 + qq[1] * k1 + qq[2] * k2 + qq[3] * k3 + qq[4] * k4 + qq[5] * k5 + qq[6] * k6 + qq[7] * k7; } }
            float sc = 0.f;
#pragma unroll
            for (int h = 0; h < 8; ++h) sc += wsm[h] * fmaxf(d[h], 0.f);
            keys[j] = mono_key(sc);
        }
        __syncthreads();
        unsigned T = 0u;
        for (int bit = 31; bit >= 0; --bit) {
            const unsigned cand = T | (1u << bit); int c = 0;
            for (int j = tid; j < n; j += NTHREADS) c += keys[j] >= cand ? 1 : 0;
#pragma unroll
            for (int o = 1; o < 64; o <<= 1) c += __shfl_xor(c, o);
            if (lane == 0) red[(bit & 1) * 8 + wave] = c;
            __syncthreads();
            int tot = 0;
#pragma unroll
            for (int w = 0; w < 8; ++w) tot += red[(bit & 1) * 8 + w];
            if (tot >= 256) T = cand;
        }
        const int j0 = tid * 16; int ngt = 0, neq = 0;
        for (int j = j0; j < j0 + 16 && j < n; ++j) { const unsigned k = keys[j]; ngt += k > T; neq += k == T; }
        cgt[tid] = ngt; ceq[tid] = neq;
        __syncthreads();
        int tot_gt = 0; for (int i = 0; i < NTHREADS; ++i) tot_gt += cgt[i];
        const int r = 256 - tot_gt;
        int pe = 0, off = 0;
        for (int i = 0; i < tid; ++i) { const int rem = r - pe; const int take = rem <= 0 ? 0 : (ceq[i] < rem ? ceq[i] : rem); off += cgt[i] + take; pe += ceq[i]; }
        for (int j = j0; j < j0 + 16 && j < n; ++j) { const unsigned k = keys[j];
            if (k > T) out[off++] = (unsigned short)j; else if (k == T) { if (pe < r) out[off++] = (unsigned short)j; ++pe; } }
    }
    __syncthreads();
}


struct EpiProj {
    static constexpr bool PERM = true, AFTER_DRAIN = false;
    int pad;
    __device__ __forceinline__ void operator()(const pg8::f32x4 (&acc)[2][2][4][2], const pg8::Unit& u, int wr, int wc, int fr, int fq) const {
        typedef float f32x2 __attribute__((ext_vector_type(2)));
        asm volatile("" : "+v"(fr), "+v"(fq));
        unsigned char* ws = P_WS;
        const int T = u.pn;
        bool do_norm = false, do_rope = false, misc = false; float scale = 1.f; const float* g = nullptr; float* ssq = nullptr;
        bf16_t* dst = (bf16_t*)(ws + WS_PROJ); int pitch = PP, col0 = 0;
        if (T == 0) { ssq = (float*)(ws + WS_SSQ_CQ); col0 = C_CQ + 64 * wc; }
        else if (T == 1) {
            if (wc < 2) { ssq = (float*)(ws + WS_SSQ_CKV); col0 = C_CKV + 64 * wc; }
            else if (wc == 2) { misc = true; col0 = C_KPE; }
            else { do_norm = true; do_rope = true; g = P_IN(13); dst = (bf16_t*)(ws + WS_KI); pitch = 64; col0 = 0; } }
        else if (T < 4) { do_norm = true; do_rope = true; g = P_IN(11); scale = SC_DSA; col0 = C_QD + 64 * (4 * (T - 2) + wc); }
        else if (T < 6) { do_rope = true; scale = SC_IDX; col0 = C_QI + 64 * (4 * (T - 4) + wc); }
        else { dst = (bf16_t*)(ws + WS_KVD); pitch = 256; if (wc < 2) { do_norm = true; do_rope = true; g = P_IN(12); col0 = 64 * wc; } else col0 = 128 + 64 * (wc - 2); }
        const int row0 = u.pm * pg8::BM + wr * 64 + fr;
        float g0[8], g1[8];
        if (do_norm) { const f32x2 a = *(const f32x2*)(g + 2 * fq), b = *(const f32x2*)(g + 8 + 2 * fq); const f32x4 c = *(const f32x4*)(g + 16 + 4 * fq), d = *(const f32x4*)(g + 32 + 8 * fq), e = *(const f32x4*)(g + 36 + 8 * fq);
            g0[0] = a.x; g0[1] = a.y; g0[2] = b.x; g0[3] = b.y; g0[4] = c.x; g0[5] = c.y; g0[6] = c.z; g0[7] = c.w; g1[0] = d.x; g1[1] = d.y; g1[2] = d.z; g1[3] = d.w; g1[4] = e.x; g1[5] = e.y; g1[6] = e.z; g1[7] = e.w; }
        f32x2 rc[8], rs[8];
        if (do_rope) { const float* rt = (const float*)(ws + WS_ROPE) + 32 + 2 * fq;
#pragma unroll
            for (int i = 0; i < 8; ++i) { const float* rr = rt + (size_t)(row0 + (i >> 2) * pg8::HALF + (i & 3) * 16) * ROPE_W; rc[i] = *(const f32x2*)rr; rs[i] = *(const f32x2*)(rr + 8); } }
#pragma unroll
        for (int ai = 0; ai < 2; ++ai)
#pragma unroll
            for (int m = 0; m < 4; ++m) { const int row = row0 + ai * pg8::HALF + m * 16;
                float v[16];
#pragma unroll
                for (int e = 0; e < 4; ++e) { v[e] = acc[ai][0][m][0][e]; v[4 + e] = acc[ai][0][m][1][e]; v[8 + e] = acc[ai][1][m][0][e]; v[12 + e] = acc[ai][1][m][1][e]; }
                if (ssq != nullptr || do_norm) { float ss = 0.f;
#pragma unroll
                    for (int e = 0; e < 16; ++e) ss += v[e] * v[e];
                    ss += __shfl_xor(ss, 16); ss += __shfl_xor(ss, 32);
                    if (ssq != nullptr) { if (fq == 0) (void)__builtin_amdgcn_global_atomic_fadd_f32((__attribute__((address_space(1))) float*)(ssq + row), ss); }
                    else { const float r = __builtin_amdgcn_rsqf(ss * (1.f / 64.f) + EPS);
#pragma unroll
                        for (int e = 0; e < 8; ++e) { v[e] *= r * g0[e]; v[8 + e] *= r * g1[e]; } } }
                if (do_rope) { const f32x2 c = rc[ai * 4 + m], s = rs[ai * 4 + m];
                    const float a0 = v[0] * c.x - v[2] * s.x, b0 = v[2] * c.x + v[0] * s.x, a1 = v[1] * c.y - v[3] * s.y, b1 = v[3] * c.y + v[1] * s.y;
                    v[0] = a0; v[2] = b0; v[1] = a1; v[3] = b1; }
                if (misc) {
                    { float sp = 0.f;
#pragma unroll
                      for (int q = 0; q < 8; ++q) sp += v[q] * v[q];
                      sp += __shfl_xor(sp, 16); sp += __shfl_xor(sp, 32); if (fq == 0) ((float*)(ws + WS_SS_PE))[row] = sp; }
                    u32x4 w; w.x = pg8::cvt_pk_bf16(v[0], v[1]); w.y = pg8::cvt_pk_bf16(v[2], v[3]); w.z = pg8::cvt_pk_bf16(v[4], v[5]); w.w = pg8::cvt_pk_bf16(v[6], v[7]);
                    *(u32x4*)(dst + (size_t)row * PP + C_KPE + 8 * fq) = w;
                    if (fq == 0) { float* wp = (float*)(ws + WS_WI) + (size_t)row * 8; const float k = 0.35355339059327373f;
                        *(f32x4*)wp = (f32x4){v[8] * k, v[9] * k, v[10] * k, v[11] * k}; *(f32x4*)(wp + 4) = (f32x4){v[12] * k, v[13] * k, v[14] * k, v[15] * k}; }
                } else {
                    u32x4 w0, w1;
                    w0.x = pg8::cvt_pk_bf16(v[0] * scale, v[1] * scale); w0.y = pg8::cvt_pk_bf16(v[2] * scale, v[3] * scale); w0.z = pg8::cvt_pk_bf16(v[4] * scale, v[5] * scale); w0.w = pg8::cvt_pk_bf16(v[6] * scale, v[7] * scale);
                    w1.x = pg8::cvt_pk_bf16(v[8] * scale, v[9] * scale); w1.y = pg8::cvt_pk_bf16(v[10] * scale, v[11] * scale); w1.z = pg8::cvt_pk_bf16(v[12] * scale, v[13] * scale); w1.w = pg8::cvt_pk_bf16(v[14] * scale, v[15] * scale);
                    bf16_t* rp = dst + (size_t)row * pitch + col0 + 8 * fq;
                    *(u32x4*)rp = w0; *(u32x4*)(rp + 32) = w1; }
            }
    }
};

struct EpiKV {
    static constexpr bool PERM = true, AFTER_DRAIN = false;
    int pad;
    __device__ __forceinline__ void operator()(const pg8::f32x4 (&acc)[2][2][4][2], const pg8::Unit& u, int wr, int wc, int fr, int fq) const {
        asm volatile("" : "+v"(fr), "+v"(fq));
        unsigned char* ws = P_WS;
        const int h = 2 * u.pn + (wc >> 1); const bool isv = (wc & 1) != 0;
        const int row0 = u.pm * pg8::BM + wr * 64 + fr;
        const float* ssq = (const float*)(ws + WS_SSQ_CKV);
        float rck[8];
#pragma unroll
        for (int i = 0; i < 8; ++i) rck[i] = ssq[row0 + (i >> 2) * pg8::HALF + (i & 3) * 16];
        if (isv) {
            bf16_t* dst = (bf16_t*)(ws + WS_KVM) + 128 * h + 64 + 8 * fq;
#pragma unroll
            for (int ai = 0; ai < 2; ++ai)
#pragma unroll
                for (int m = 0; m < 4; ++m) { const int row = row0 + ai * pg8::HALF + m * 16; const float rs = __builtin_amdgcn_rsqf(rck[ai * 4 + m] * (1.f / 128.f) + EPS);
                    const pg8::f32x4 a0 = acc[ai][0][m][0] * rs, a1 = acc[ai][0][m][1] * rs, b0 = acc[ai][1][m][0] * rs, b1 = acc[ai][1][m][1] * rs;
                    u32x4 w0, w1; w0.x = pg8::cvt_pk_bf16(a0[0], a0[1]); w0.y = pg8::cvt_pk_bf16(a0[2], a0[3]); w0.z = pg8::cvt_pk_bf16(a1[0], a1[1]); w0.w = pg8::cvt_pk_bf16(a1[2], a1[3]);
                    w1.x = pg8::cvt_pk_bf16(b0[0], b0[1]); w1.y = pg8::cvt_pk_bf16(b0[2], b0[3]); w1.z = pg8::cvt_pk_bf16(b1[0], b1[1]); w1.w = pg8::cvt_pk_bf16(b1[2], b1[3]);
                    bf16_t* rp = dst + (size_t)row * 1024; *(u32x4*)rp = w0; *(u32x4*)(rp + 32) = w1; }
        } else {
            const float* g = P_IN(10); const float* spe = (const float*)(ws + WS_SS_PE);
            float sp[8];
#pragma unroll
            for (int i = 0; i < 8; ++i) sp[i] = spe[row0 + (i >> 2) * pg8::HALF + (i & 3) * 16];
            bf16_t* km = (bf16_t*)(ws + WS_KM) + 96 * h;
            float rr[8];
            { const f32x4 ga = *(const f32x4*)(g + 8 * fq), gb = *(const f32x4*)(g + 8 * fq + 4), gc = *(const f32x4*)(g + 32 + 8 * fq), gd = *(const f32x4*)(g + 36 + 8 * fq);
#pragma unroll
              for (int i = 0; i < 8; ++i) { const int ai = i >> 2, m = i & 3; const int row = row0 + ai * pg8::HALF + m * 16; const float rs = __builtin_amdgcn_rsqf(rck[i] * (1.f / 128.f) + EPS);
                const pg8::f32x4 a0 = acc[ai][0][m][0] * rs, a1 = acc[ai][0][m][1] * rs, b0 = acc[ai][1][m][0] * rs, b1 = acc[ai][1][m][1] * rs;
                float ss = ((a0[0] * a0[0] + a0[1] * a0[1]) + (a0[2] * a0[2] + a0[3] * a0[3])) + ((a1[0] * a1[0] + a1[1] * a1[1]) + (a1[2] * a1[2] + a1[3] * a1[3]))
                         + ((b0[0] * b0[0] + b0[1] * b0[1]) + (b0[2] * b0[2] + b0[3] * b0[3])) + ((b1[0] * b1[0] + b1[1] * b1[1]) + (b1[2] * b1[2] + b1[3] * b1[3]));
                ss += __shfl_xor(ss, 16); ss += __shfl_xor(ss, 32);
                const float r = __builtin_amdgcn_rsqf((ss + sp[i]) * (1.f / 96.f) + EPS); rr[i] = r;
                const pg8::f32x4 o0 = a0 * ga * r, o1 = a1 * gb * r, o2 = b0 * gc * r, o3 = b1 * gd * r;
                u32x4 w0, w1; w0.x = pg8::cvt_pk_bf16(o0[0], o0[1]); w0.y = pg8::cvt_pk_bf16(o0[2], o0[3]); w0.z = pg8::cvt_pk_bf16(o1[0], o1[1]); w0.w = pg8::cvt_pk_bf16(o1[2], o1[3]);
                w1.x = pg8::cvt_pk_bf16(o2[0], o2[1]); w1.y = pg8::cvt_pk_bf16(o2[2], o2[3]); w1.z = pg8::cvt_pk_bf16(o3[0], o3[1]); w1.w = pg8::cvt_pk_bf16(o3[2], o3[3]);
                bf16_t* rp = km + (size_t)row * 768; *(u32x4*)(rp + 8 * fq) = w0; *(u32x4*)(rp + 32 + 8 * fq) = w1; } }
            __builtin_amdgcn_sched_barrier(0);
            { int fq2 = fq, fr2 = fr; asm volatile("" : "+v"(fq2), "+v"(fr2));
              const int row2 = u.pm * pg8::BM + wr * 64 + fr2;
              const f32x4 gp1 = *(const f32x4*)(g + 64 + 4 * fq2), gp2 = *(const f32x4*)(g + 80 + 4 * fq2);
              const bf16_t* pe = (const bf16_t*)(ws + WS_PROJ) + C_KPE + 4 * fq2; const float* rt = (const float*)(ws + WS_ROPE) + 4 * fq2;
              u32x2 x1[8], x2[8]; f32x4 cs[8], sn[8];
#pragma unroll
              for (int i = 0; i < 8; ++i) { const size_t r_ = (size_t)(row2 + (i >> 2) * pg8::HALF + (i & 3) * 16); x1[i] = *(const u32x2*)(pe + r_ * PP); x2[i] = *(const u32x2*)(pe + r_ * PP + 16); cs[i] = *(const f32x4*)(rt + r_ * ROPE_W); sn[i] = *(const f32x4*)(rt + r_ * ROPE_W + 16); }
#pragma unroll
              for (int i = 0; i < 8; ++i) { const int row = row2 + (i >> 2) * pg8::HALF + (i & 3) * 16; const float r = rr[i];
                const f32x4 y1 = (f32x4){bflo(x1[i].x), bfhi(x1[i].x), bflo(x1[i].y), bfhi(x1[i].y)} * gp1 * r, y2 = (f32x4){bflo(x2[i].x), bfhi(x2[i].x), bflo(x2[i].y), bfhi(x2[i].y)} * gp2 * r;
                const f32x4 p1 = y1 * cs[i] - y2 * sn[i], p2 = y2 * cs[i] + y1 * sn[i];
                u32x2 q1, q2; q1.x = pg8::cvt_pk_bf16(p1[0], p1[1]); q1.y = pg8::cvt_pk_bf16(p1[2], p1[3]); q2.x = pg8::cvt_pk_bf16(p2[0], p2[1]); q2.y = pg8::cvt_pk_bf16(p2[2], p2[3]);
                bf16_t* rp = km + (size_t)row * 768; *(u32x2*)(rp + 64 + 4 * fq2) = q1; *(u32x2*)(rp + 80 + 4 * fq2) = q2; } }
        }
    }
};


namespace fa {
typedef short bf16x8 __attribute__((ext_vector_type(8)));
typedef short s16x4 __attribute__((ext_vector_type(4)));
typedef float f32x16 __attribute__((ext_vector_type(16)));
typedef __attribute__((address_space(3))) const char* lds_cptr;
struct CfgMLA   { static constexpr int DQK = 96,  DV = 64,  QP = 768, KP = 768,  VP = 1024, OP = 1024, QHS = 96,  KHS = 96,  VHS = 128, OHS = 64;  static constexpr bool CAUSAL = true,  QNORM = false; };
struct CfgCross { static constexpr int DQK = 128, DV = 128, QP = 512, KP = 1024, VP = 1024, OP = 512,  QHS = 128, KHS = 128, VHS = 128, OHS = 128; static constexpr bool CAUSAL = false, QNORM = true;  };
__device__ __forceinline__ int crow(int r, int hi) { return (r & 3) + 8 * (r >> 2) + 4 * hi; }
__device__ __forceinline__ void glds16(const void* g, unsigned lds_dst) { unsigned sv;
    asm volatile("s_mov_b32 %0, m0\n\ts_mov_b32 m0, %2\n\ts_nop 0\n\tglobal_load_lds_dwordx4 %1, off\n\ts_mov_b32 m0, %0" : "=&s"(sv) : "v"(g), "s"(lds_dst) : "memory"); }
__device__ __forceinline__ s16x4 vtr(lds_cptr p) { typedef short v4i16_t __attribute__((ext_vector_type(4))); return __builtin_bit_cast(s16x4, __builtin_amdgcn_ds_read_tr16_b64_v4i16((__attribute__((address_space(3))) v4i16_t*)p)); }
__device__ __forceinline__ unsigned cvtpk(float lo, float hi) { typedef float f2 __attribute__((ext_vector_type(2))); typedef __bf16 b2 __attribute__((ext_vector_type(2))); f2 v = {lo, hi}; b2 b = __builtin_convertvector(v, b2); return __builtin_bit_cast(unsigned, b); }
#define MLA_WAIT_BAR() asm volatile("s_waitcnt vmcnt(0) lgkmcnt(0)\n\ts_barrier" ::: "memory")

template <class C, int THR> __device__ __forceinline__ void unit(long q_row0, long kv_row0, int h, int NT, const bf16_t* Q, const bf16_t* K, const bf16_t* V, bf16_t* O, LAS unsigned char* L, const float* qgain = nullptr, float qscale = 1.f) {
    constexpr int DQK = C::DQK, DV = C::DV, QP = C::QP, KP = C::KP, VP = C::VP, OP = C::OP, NKC = DQK / 8, NDB = DV / 32;
    constexpr int KSLOT = NKC * 1024, VSLOT = NDB * 4096, SLOT = KSLOT + VSLOT, NSLOT = 3, LDS_WS = NSLOT * SLOT, LDS_OST = 0  ;
    static_assert(LDS_WS + 8 * 256 <= RING_BYTES && 8 * 32 * DV * 2 <= NSLOT * SLOT, "fa lds");
    const int tid = tid_opaque(), lane = tid & 63, r32 = lane & 31, hi = lane >> 5; const int wid = __builtin_amdgcn_readfirstlane(tid >> 6);
    const bf16_t* Qw = Q + (q_row0 + wid * 32) * QP + h * C::QHS;
    const bf16_t* Kh = K + kv_row0 * KP + h * C::KHS; const bf16_t* Vh = V + kv_row0 * VP + h * C::VHS;
    const unsigned lds0 = (unsigned)(uintptr_t)L;
    LAS float* wsf = (LAS float*)(L + LDS_WS) + wid * 64;
    const bf16_t* ksrc0 = Kh + (long)lane * KP + wid * 8; const bf16_t* ksrc1 = ksrc0 + 64;
    const bf16_t* vsrc = Vh + (long)(16 * (wid & 3) + (lane >> 2)) * VP + (wid >> 2) * 32 + (lane & 3) * 8;
    const unsigned kdst0 = lds0 + wid * 1024, kdst1 = kdst0 + 8192, vdst = lds0 + KSLOT + wid * 1024;
#define MLA_DMA(t, slot) do { glds16(ksrc0 + (long)(t) * 64 * KP, (unsigned)__builtin_amdgcn_readfirstlane(kdst0 + (slot))); \
        if (8 + wid < NKC) glds16(ksrc1 + (long)(t) * 64 * KP, (unsigned)__builtin_amdgcn_readfirstlane(kdst1 + (slot))); \
        glds16(vsrc + (long)(t) * 64 * VP, (unsigned)__builtin_amdgcn_readfirstlane(vdst + (slot))); \
        if (NDB == 4) glds16(vsrc + (long)(t) * 64 * VP + 64, (unsigned)__builtin_amdgcn_readfirstlane(vdst + 8192 + (slot))); } while (0)
    const lds_cptr kp0 = (lds_cptr)L + hi * 1024 + r32 * 16;
    const lds_cptr vp0 = (lds_cptr)L + KSLOT + ((lane >> 4) & 1) * 32 + (lane & 3) * 8 + (4 * hi + ((lane & 15) >> 2)) * 64;
    MLA_DMA(0, 0); if (NT > 1) MLA_DMA(1, SLOT);
    bf16x8 qr[DQK / 16];
#pragma unroll
    for (int d0 = 0; d0 < DQK / 16; ++d0) qr[d0] = *reinterpret_cast<const bf16x8*>(Qw + (long)r32 * QP + d0 * 16 + hi * 8);
    if constexpr (C::QNORM) {
        float sq = 0.f;
#pragma unroll
        for (int d0 = 0; d0 < DQK / 16; ++d0)
#pragma unroll
            for (int j = 0; j < 8; ++j) { const float x = __builtin_bit_cast(float, (unsigned)(unsigned short)qr[d0][j] << 16); sq += x * x; }
        { auto rr = __builtin_amdgcn_permlane32_swap(__float_as_uint(sq), __float_as_uint(sq), false, false); sq = __uint_as_float(rr[0]) + __uint_as_float(rr[1]); }
        const float rs = qscale * __builtin_amdgcn_rsqf(sq * (1.0f / DQK) + EPS);
#pragma unroll
        for (int d0 = 0; d0 < DQK / 16; ++d0) { const f32x4 g0 = *(const f32x4*)(qgain + 16 * d0 + 8 * hi), g1 = *(const f32x4*)(qgain + 16 * d0 + 8 * hi + 4); float x[8];
#pragma unroll
            for (int j = 0; j < 8; ++j) x[j] = __builtin_bit_cast(float, (unsigned)(unsigned short)qr[d0][j] << 16) * rs * (j < 4 ? g0[j] : g1[j - 4]);
            typedef unsigned u4 __attribute__((ext_vector_type(4)));
            u4 w; w.x = cvtpk(x[0], x[1]); w.y = cvtpk(x[2], x[3]); w.z = cvtpk(x[4], x[5]); w.w = cvtpk(x[6], x[7]); qr[d0] = __builtin_bit_cast(bf16x8, w); }
    }
    float mrow = -INFINITY, l0 = 0.f, l1 = 0.f, l2 = 0.f, l3 = 0.f; f32x16 o[NDB];
#pragma unroll
    for (int d0 = 0; d0 < NDB; ++d0) o[d0] = f32x16{};
    const int qrel = wid * 32 + r32;
    const int ndma = 1 + ((8 + wid < NKC) ? 1 : 0) + (NDB == 4 ? 2 : 1);
#define MLA_WAIT_KEEP(cond_keep) do { if (cond_keep) { if (ndma == 2) asm volatile("s_waitcnt vmcnt(2) lgkmcnt(0)\n\ts_barrier" ::: "memory"); else if (ndma == 3) asm volatile("s_waitcnt vmcnt(3) lgkmcnt(0)\n\ts_barrier" ::: "memory"); else asm volatile("s_waitcnt vmcnt(4) lgkmcnt(0)\n\ts_barrier" ::: "memory"); } else MLA_WAIT_BAR(); } while (0)
    MLA_WAIT_BAR();
#define FA_BLOCK_A(HN) do { bf16x8 kfr[KD]; if (HN) { _Pragma("unroll") for (int g_ = 0; g_ < KD; ++g_) kfr[g_] = FA_KLD((g_ >> 1) * 2048 + (g_ & 1) * 512); } _Pragma("unroll") for (int g = 0; g < NG; ++g) { if (HN) { const int d0 = g >> 1; const bf16x8 kf = kfr[g % KD]; if (g + KD < NG) kfr[g % KD] = FA_KLD(((g + KD) >> 1) * 2048 + ((g + KD) & 1) * 512); if (g & 1) pn1 = __builtin_amdgcn_mfma_f32_32x32x16_bf16(kf, qr[d0], pn1, 0, 0, 0); else pn0 = __builtin_amdgcn_mfma_f32_32x32x16_bf16(kf, qr[d0], pn0, 0, 0, 0); } if (g < 8) { _Pragma("unroll") for (int e = 0; e < 4; ++e) { const int r = (4 * g + e) & 15; if (g < 4) pc0[r] = __builtin_amdgcn_exp2f(pc0[r] - mrow); else pc1[r] = __builtin_amdgcn_exp2f(pc1[r] - mrow); } if (g < 4) FA_PIN(pc0); else FA_PIN(pc1); } else if (g < 12) { const int ks = g - 8, bb = (ks & 1) * 8; const f32x16& P = (ks < 2) ? pc0 : pc1; FA_ADD(l0, P[bb + 0]); FA_ADD(l1, P[bb + 1]); FA_ADD(l2, P[bb + 2]); FA_ADD(l3, P[bb + 3]); FA_ADD(l0, P[bb + 4]); FA_ADD(l1, P[bb + 5]); FA_ADD(l2, P[bb + 6]); FA_ADD(l3, P[bb + 7]); typedef unsigned u4 __attribute__((ext_vector_type(4))); u4 w; w.x = cvtpk(P[bb + 0], P[bb + 1]); w.y = cvtpk(P[bb + 2], P[bb + 3]); w.z = cvtpk(P[bb + 4], P[bb + 5]); w.w = cvtpk(P[bb + 6], P[bb + 7]); pa[ks] = __builtin_bit_cast(bf16x8, w); FA_PIN(pa[ks]); } FA_SB(); } } while (0)
#define FA_PIN(x) asm volatile("" : "+v"(x))
#define FA_ADD(acc, x) asm("v_add_f32 %0, %0, %1" : "+v"(acc) : "v"(x))
#define FA_SB() __builtin_amdgcn_sched_barrier(0)
#define FA_KLD(off) (*(const __attribute__((address_space(3))) bf16x8*)(kpn + (off)))
#define FA_MASK(P0, P1, tt) do { const int jb_ = (tt) - (NT - 4); if (C::CAUSAL && jb_ >= 0) { const int kb_ = 64 * jb_ + 4 * hi; \
        _Pragma("unroll") for (int r = 0; r < 16; ++r) { const int kv = kb_ + (r & 3) + 8 * (r >> 2); if (kv > qrel) P0[r] = -INFINITY; if (kv + 32 > qrel) P1[r] = -INFINITY; } } } while (0)
#define FA_DECIDE(RM) do { float rm_ = (RM); { auto rr = __builtin_amdgcn_permlane32_swap(__float_as_uint(rm_), __float_as_uint(rm_), false, false); rm_ = fmaxf(__uint_as_float(rr[0]), __uint_as_float(rr[1])); } \
        if (__any(rm_ > mrow + (float)THR)) { const float mnew = fmaxf(mrow, rm_); const float alpha = __builtin_amdgcn_exp2f(mrow - mnew); mrow = mnew; l0 *= alpha; l1 *= alpha; l2 *= alpha; l3 *= alpha; \
            if (hi == 0) wsf[r32] = alpha; asm volatile("s_waitcnt lgkmcnt(0)" ::: "memory"); \
            _Pragma("unroll") for (int r = 0; r < 16; ++r) { const float f = wsf[crow(r, hi)]; _Pragma("unroll") for (int d0 = 0; d0 < NDB; ++d0) o[d0][r] *= f; } } } while (0)
    constexpr int NG = DQK / 8, NPV = NDB * 4, KD = 4, VD = 3;
    int slot = 0, slot2 = 2 * SLOT;
    f32x16 pc0, pc1;
    { const lds_cptr kpn = kp0;
      pc0 = f32x16{}; pc1 = f32x16{};
#pragma unroll
      for (int d0 = 0; d0 < DQK / 16; ++d0) { pc0 = __builtin_amdgcn_mfma_f32_32x32x16_bf16(FA_KLD(d0 * 2048), qr[d0], pc0, 0, 0, 0); pc1 = __builtin_amdgcn_mfma_f32_32x32x16_bf16(FA_KLD(d0 * 2048 + 512), qr[d0], pc1, 0, 0, 0); }
      FA_MASK(pc0, pc1, 0);
      float rma = fmaxf(pc0[0], pc1[0]);
#pragma unroll
      for (int r = 1; r < 16; ++r) rma = fmaxf(rma, fmaxf(pc0[r], pc1[r]));
      FA_DECIDE(rma); }
    for (int t = 0; t < NT; ++t) {
        if (t + 2 < NT) MLA_DMA(t + 2, slot2);
        const bool has_next = t + 1 < NT;
        const lds_cptr kpn = kp0 + ((slot == 2 * SLOT) ? 0 : slot + SLOT);
        f32x16 pn0 = f32x16{}, pn1 = f32x16{}; bf16x8 pa[4];
        FA_SB();
        if (has_next) FA_BLOCK_A(true); else FA_BLOCK_A(false);
        if (has_next) FA_MASK(pn0, pn1, t + 1);
        const lds_cptr vp = vp0 + slot;
        float rma = -INFINITY, rmb = -INFINITY;
        FA_SB();
        s16x4 vlo[VD], vhh[VD];
#pragma unroll
        for (int i = 0; i < VD; ++i) { vlo[i] = vtr(vp + (i >> 2) * 4096 + (i & 3) * 1024); vhh[i] = vtr(vp + (i >> 2) * 4096 + (i & 3) * 1024 + 512); }
#pragma unroll
        for (int i = 0; i < NPV; ++i) { const int d0 = i >> 2, ks = i & 3;
            const bf16x8 vf = (bf16x8){vlo[i % VD][0], vlo[i % VD][1], vlo[i % VD][2], vlo[i % VD][3], vhh[i % VD][0], vhh[i % VD][1], vhh[i % VD][2], vhh[i % VD][3]};
            if (i + VD < NPV) { const int d1 = (i + VD) >> 2, k1 = (i + VD) & 3; vlo[i % VD] = vtr(vp + d1 * 4096 + k1 * 1024); vhh[i % VD] = vtr(vp + d1 * 4096 + k1 * 1024 + 512); }
            o[d0] = __builtin_amdgcn_mfma_f32_32x32x16_bf16(pa[ks], vf, o[d0], 0, 0, 0);
            if (i < 8) { rma = fmaxf(rma, fmaxf(pn0[2 * i], pn1[2 * i])); rmb = fmaxf(rmb, fmaxf(pn0[2 * i + 1], pn1[2 * i + 1])); FA_PIN(rma); FA_PIN(rmb); }
            FA_SB();
        }
        if (has_next) FA_DECIDE(fmaxf(rma, rmb));
        MLA_WAIT_BAR();
        pc0 = pn0; pc1 = pn1;
        slot2 = slot; slot = (slot == 2 * SLOT) ? 0 : slot + SLOT;
    }
#undef FA_PIN
#undef FA_ADD
#undef FA_BLOCK_A
#undef FA_SB
#undef FA_KLD
#undef FA_MASK
#undef FA_DECIDE
    float lsum = (l0 + l1) + (l2 + l3);
    { auto rr = __builtin_amdgcn_permlane32_swap(__float_as_uint(lsum), __float_as_uint(lsum), false, false); lsum = __uint_as_float(rr[0]) + __uint_as_float(rr[1]); }
    if (hi == 0) wsf[32 + r32] = lsum;
    asm volatile("s_waitcnt lgkmcnt(0)" ::: "memory");
    float rli[16];
#pragma unroll
    for (int r = 0; r < 16; ++r) rli[r] = __builtin_amdgcn_rcpf(wsf[32 + crow(r, hi)]);
    bf16_t* Ow = O + (q_row0 + wid * 32) * OP + h * C::OHS;
    { LAS bf16_t* stg = (LAS bf16_t*)(L + LDS_OST) + wid * (32 * DV);
#pragma unroll
      for (int r = 0; r < 16; ++r) { const int orow = crow(r, hi);
#pragma unroll
          for (int d0 = 0; d0 < NDB; ++d0) stg[orow * DV + d0 * 32 + r32] = (bf16_t)f2bf(o[d0][r] * rli[r]); }
      asm volatile("s_waitcnt lgkmcnt(0)" ::: "memory");
      constexpr int CPR = DV / 8;
#pragma unroll
      for (int i = 0; i < 32 * CPR / 64; ++i) { const int row = i * (64 / CPR) + lane / CPR, ch = lane % CPR; const u32x4 v = *(const LAS u32x4*)(stg + row * DV + ch * 8); *(u32x4*)(Ow + (long)row * OP + ch * 8) = v; } }
    asm volatile("s_waitcnt lgkmcnt(0)\n\ts_barrier" ::: "memory");
#undef MLA_DMA
#undef MLA_WAIT_KEEP
}
template <int THR> __device__ __forceinline__ void mla_phase(const bf16_t* Q, const bf16_t* K, const bf16_t* V, bf16_t* O, LAS unsigned char* L, int G, int bid) {
    if (G == 256) {
        const int vcu = (bid % 8) * (G / 8) + bid / 8, s = vcu & 7, bh = vcu >> 3;
        for (int i = 0; i < 4; ++i) { const int qb = (i == 0) ? s : (i == 1) ? 15 - s : (i == 2) ? 16 + s : 31 - s; const long rb = (long)(bh / 8) * SEQ;
            unit<CfgMLA, THR>(rb + qb * 256, rb, bh % 8, 4 * qb + 4, Q, K, V, O, L); }
    } else {
        for (int u = bid; u < BATCH * 8 * 32; u += G) { const long rb = (long)(u / 256) * SEQ; const int qb = u % 32; unit<CfgMLA, THR>(rb + qb * 256, rb, (u / 32) % 8, 4 * qb + 4, Q, K, V, O, L); }
    }
}
template <int THR> __device__ __forceinline__ void cross_phase(const bf16_t* Q, const bf16_t* K, const bf16_t* V, bf16_t* O, const float* qgain, LAS unsigned char* L, int G, int bid) {
    for (int u = bid; u < BATCH * 4 * 32; u += G) { const int b = u / 128, h = (u / 32) % 4, qb = u % 32;
        unit<CfgCross, THR>((long)b * SEQ + qb * 256, (long)b * NMEM, h, NMEM / 64, Q, K, V, O, L, qgain, SC_MEM); }
}
}


namespace fa2 {
typedef short bf16x8 __attribute__((ext_vector_type(8)));
typedef short s16x4 __attribute__((ext_vector_type(4)));
typedef float f32x16 __attribute__((ext_vector_type(16)));
typedef __attribute__((address_space(3))) const char* lds_cptr;
struct CfgMLA   { static constexpr int DQK = 96,  DV = 64,  QP = 768, KP = 768,  VP = 1024, OP = 1024, QHS = 96,  KHS = 96,  VHS = 128, OHS = 64;  static constexpr bool CAUSAL = true,  QNORM = true,  QROPE = true;  };
struct CfgCross { static constexpr int DQK = 128, DV = 128, QP = 512, KP = 1024, VP = 1024, OP = 512,  QHS = 128, KHS = 128, VHS = 128, OHS = 128; static constexpr bool CAUSAL = false, QNORM = true,  QROPE = false; };
struct TagT { static constexpr bool value = true; }; struct TagF { static constexpr bool value = false; };
__device__ __forceinline__ int crow(int r, int hi) { return (r & 3) + 8 * (r >> 2) + 4 * hi; }
__device__ __forceinline__ void glds16(const void* g, unsigned lds_dst) { unsigned sv;
    asm volatile("s_mov_b32 %0, m0\n\ts_mov_b32 m0, %2\n\ts_nop 0\n\tglobal_load_lds_dwordx4 %1, off\n\ts_mov_b32 m0, %0" : "=&s"(sv) : "v"(g), "s"(lds_dst) : "memory"); }
__device__ __forceinline__ s16x4 vtr(lds_cptr p) { typedef short v4i16_t __attribute__((ext_vector_type(4))); return __builtin_bit_cast(s16x4, __builtin_amdgcn_ds_read_tr16_b64_v4i16((__attribute__((address_space(3))) v4i16_t*)p)); }
__device__ __forceinline__ unsigned cvtpk(float lo, float hi) { typedef float f2 __attribute__((ext_vector_type(2))); typedef __bf16 b2 __attribute__((ext_vector_type(2))); f2 v = {lo, hi}; b2 b = __builtin_convertvector(v, b2); return __builtin_bit_cast(unsigned, b); }
#define MLA_WAIT_BAR() asm volatile("s_waitcnt vmcnt(0) lgkmcnt(0)\n\ts_barrier" ::: "memory")

template <class C, int THR> __device__ __forceinline__ void unit(long q_row0, long kv_row0, int h, int NT, const bf16_t* Q, const bf16_t* K, const bf16_t* V, bf16_t* O, LAS unsigned char* L, const float* qgain = nullptr, float qscale = 1.f, const float* rope = nullptr, bool pre_issued = false, bool issue_next = false) {
    constexpr int DQK = C::DQK, DV = C::DV, QP = C::QP, KP = C::KP, VP = C::VP, OP = C::OP, NKC = DQK / 8, NDB = DV / 32;
    constexpr int KSLOT = NKC * 1024, VSLOT = NDB * 4096, SLOT = KSLOT + VSLOT, NSLOT = 3, LDS_WS = NSLOT * SLOT, LDS_OST = 65536  ;
    static_assert(LDS_WS + 8 * 256 <= LDS_OST && LDS_OST + 8 * 32 * DV * 2 <= RING_BYTES, "fa lds");
    const int tid = tid_opaque(), lane = tid & 63, r32 = lane & 31, hi = lane >> 5; const int wid = __builtin_amdgcn_readfirstlane(tid >> 6);
    const bf16_t* Qw = Q + (q_row0 + wid * 32) * QP + h * C::QHS;
    const bf16_t* Kh = K + kv_row0 * KP + h * C::KHS; const bf16_t* Vh = V + kv_row0 * VP + h * C::VHS;
    const unsigned lds0 = (unsigned)(uintptr_t)L;
    LAS float* wsf = (LAS float*)(L + LDS_WS) + wid * 64;
    const bf16_t* ksrc0 = Kh + (long)lane * KP + wid * 8; const bf16_t* ksrc1 = ksrc0 + 64;
    const bf16_t* vsrc = Vh + (long)(16 * (wid & 3) + (lane >> 2)) * VP + (wid >> 2) * 32 + (lane & 3) * 8;
    const unsigned kdst0 = lds0 + wid * 1024, kdst1 = kdst0 + 8192, vdst = lds0 + KSLOT + wid * 1024;
#define MLA_DMA(t, slot) do { glds16(ksrc0 + (long)(t) * 64 * KP, (unsigned)__builtin_amdgcn_readfirstlane(kdst0 + (slot))); \
        if (8 + wid < NKC) glds16(ksrc1 + (long)(t) * 64 * KP, (unsigned)__builtin_amdgcn_readfirstlane(kdst1 + (slot))); \
        glds16(vsrc + (long)(t) * 64 * VP, (unsigned)__builtin_amdgcn_readfirstlane(vdst + (slot))); \
        if (NDB == 4) glds16(vsrc + (long)(t) * 64 * VP + 64, (unsigned)__builtin_amdgcn_readfirstlane(vdst + 8192 + (slot))); } while (0)
    const lds_cptr kp0 = (lds_cptr)L + hi * 1024 + r32 * 16;
    const lds_cptr vp0 = (lds_cptr)L + KSLOT + ((lane >> 4) & 1) * 32 + (lane & 3) * 8 + (4 * hi + ((lane & 15) >> 2)) * 64;
    if (!pre_issued) { MLA_DMA(0, 0); if (NT > 1) MLA_DMA(1, SLOT); }
    bf16x8 qr[DQK / 16];
#pragma unroll
    for (int d0 = 0; d0 < DQK / 16; ++d0) qr[d0] = *reinterpret_cast<const bf16x8*>(Qw + (long)r32 * QP + d0 * 16 + hi * 8);
    if constexpr (C::QNORM) {
        float sq = 0.f;
#pragma unroll
        for (int d0 = 0; d0 < DQK / 16; ++d0)
#pragma unroll
            for (int j = 0; j < 8; ++j) { const float x = __builtin_bit_cast(float, (unsigned)(unsigned short)qr[d0][j] << 16); sq += x * x; }
        { auto rr = __builtin_amdgcn_permlane32_swap(__float_as_uint(sq), __float_as_uint(sq), false, false); sq = __uint_as_float(rr[0]) + __uint_as_float(rr[1]); }
        const float rs = qscale * __builtin_amdgcn_rsqf(sq * (1.0f / DQK) + EPS);
        float xq[DQK / 16][8];
#pragma unroll
        for (int d0 = 0; d0 < DQK / 16; ++d0) { const f32x4 g0 = *(const f32x4*)(qgain + 16 * d0 + 8 * hi), g1 = *(const f32x4*)(qgain + 16 * d0 + 8 * hi + 4);
#pragma unroll
            for (int j = 0; j < 8; ++j) xq[d0][j] = __builtin_bit_cast(float, (unsigned)(unsigned short)qr[d0][j] << 16) * rs * (j < 4 ? g0[j] : g1[j - 4]); }
        if constexpr (C::QROPE) {
            const float* rt = rope + (q_row0 + wid * 32 + r32) * ROPE_W + 8 * hi;
            const f32x4 c0 = *(const f32x4*)rt, c1 = *(const f32x4*)(rt + 4), s0 = *(const f32x4*)(rt + 16), s1 = *(const f32x4*)(rt + 20);
#pragma unroll
            for (int j = 0; j < 8; ++j) { const float c = j < 4 ? c0[j] : c1[j - 4], sn = j < 4 ? s0[j] : s1[j - 4]; const float a = xq[4][j], b = xq[5][j]; xq[4][j] = a * c - b * sn; xq[5][j] = b * c + a * sn; }
        }
#pragma unroll
        for (int d0 = 0; d0 < DQK / 16; ++d0) { typedef unsigned u4 __attribute__((ext_vector_type(4)));
            u4 w; w.x = cvtpk(xq[d0][0], xq[d0][1]); w.y = cvtpk(xq[d0][2], xq[d0][3]); w.z = cvtpk(xq[d0][4], xq[d0][5]); w.w = cvtpk(xq[d0][6], xq[d0][7]); qr[d0] = __builtin_bit_cast(bf16x8, w); }
    }
    const bf16x8 kone = (bf16x8){(short)(hi == 0 ? 0x3F80 : 0), 0, 0, 0, 0, 0, 0, 0}; bf16x8 qx = (bf16x8){0, 0, 0, 0, 0, 0, 0, 0};
    float mrow = 0.f, l0 = 0.f, l1 = 0.f, l2 = 0.f, l3 = 0.f; f32x16 o[NDB];
#pragma unroll
    for (int d0 = 0; d0 < NDB; ++d0) o[d0] = f32x16{};
    const int qrel = wid * 32 + r32;
    const int ndma = 1 + ((8 + wid < NKC) ? 1 : 0) + (NDB == 4 ? 2 : 1);
#define MLA_WAIT_KEEP(cond_keep) do { if (cond_keep) { if (ndma == 2) asm volatile("s_waitcnt vmcnt(2) lgkmcnt(0)\n\ts_barrier" ::: "memory"); else if (ndma == 3) asm volatile("s_waitcnt vmcnt(3) lgkmcnt(0)\n\ts_barrier" ::: "memory"); else asm volatile("s_waitcnt vmcnt(4) lgkmcnt(0)\n\ts_barrier" ::: "memory"); } else MLA_WAIT_BAR(); } while (0)
    MLA_WAIT_BAR();
#define FA_BLOCK_A(HN) do { bf16x8 kfr[KD]; if (HN) { _Pragma("unroll") for (int g_ = 0; g_ < KD; ++g_) kfr[g_] = FA_KLD((g_ >> 1) * 2048 + (g_ & 1) * 512); } _Pragma("unroll") for (int gg = 0; gg < NG + 2; ++gg) { if (HN) { if (gg == 0) pn0 = __builtin_amdgcn_mfma_f32_32x32x16_bf16(kone, qx, f32x16{}, 0, 0, 0); else if (gg == 1) pn1 = __builtin_amdgcn_mfma_f32_32x32x16_bf16(kone, qx, f32x16{}, 0, 0, 0); else { const int g = gg - 2, d0 = g >> 1; const bf16x8 kf = kfr[g % KD]; if (g + KD < NG) kfr[g % KD] = FA_KLD(((g + KD) >> 1) * 2048 + ((g + KD) & 1) * 512); if (g & 1) pn1 = __builtin_amdgcn_mfma_f32_32x32x16_bf16(kf, qr[d0], pn1, 0, 0, 0); else pn0 = __builtin_amdgcn_mfma_f32_32x32x16_bf16(kf, qr[d0], pn0, 0, 0, 0); } } if (gg < 8) { _Pragma("unroll") for (int e = 0; e < 4; ++e) { const int r = (4 * gg + e) & 15; if (gg < 4) pc0[r] = __builtin_amdgcn_exp2f(pc0[r]); else pc1[r] = __builtin_amdgcn_exp2f(pc1[r]); } if (gg < 4) FA_PIN(pc0); else FA_PIN(pc1); } else if (gg < 12) { const int ks = gg - 8, bb = (ks & 1) * 8; const f32x16& P = (ks < 2) ? pc0 : pc1; FA_ADD(l0, P[bb + 0]); FA_ADD(l1, P[bb + 1]); FA_ADD(l2, P[bb + 2]); FA_ADD(l3, P[bb + 3]); FA_ADD(l0, P[bb + 4]); FA_ADD(l1, P[bb + 5]); FA_ADD(l2, P[bb + 6]); FA_ADD(l3, P[bb + 7]); typedef unsigned u4 __attribute__((ext_vector_type(4))); u4 w; w.x = cvtpk(P[bb + 0], P[bb + 1]); w.y = cvtpk(P[bb + 2], P[bb + 3]); w.z = cvtpk(P[bb + 4], P[bb + 5]); w.w = cvtpk(P[bb + 6], P[bb + 7]); pa[ks] = __builtin_bit_cast(bf16x8, w); FA_PIN(pa[ks]); } FA_SB(); } } while (0)
#define FA_PIN(x) asm volatile("" : "+v"(x))
#define FA_ADD(acc, x) asm("v_add_f32 %0, %0, %1" : "+v"(acc) : "v"(x))
#define FA_SB() __builtin_amdgcn_sched_barrier(0)
#define FA_KLD(off) (*(const __attribute__((address_space(3))) bf16x8*)(kpn + (off)))
#define FA_MASK(P0, P1, tt) do { const int jb_ = (tt) - (NT - 4); if (C::CAUSAL && jb_ >= 0) { const int kb_ = 64 * jb_ + 4 * hi; \
        _Pragma("unroll") for (int r = 0; r < 16; ++r) { const int kv = kb_ + (r & 3) + 8 * (r >> 2); if (kv > qrel) P0[r] = -INFINITY; if (kv + 32 > qrel) P1[r] = -INFINITY; } } } while (0)
#define FA_BF16R(x) __builtin_bit_cast(float, f2bf(x) << 16)
#define FA_SETQX() do { const short nb_ = (short)f2bf(-mrow); qx = (bf16x8){(short)(hi == 0 ? nb_ : (short)0), 0, 0, 0, 0, 0, 0, 0}; } while (0)
#define FA_DECIDE(RM, P0, P1) do { float rm_ = (RM); { auto rr = __builtin_amdgcn_permlane32_swap(__float_as_uint(rm_), __float_as_uint(rm_), false, false); rm_ = fmaxf(__uint_as_float(rr[0]), __uint_as_float(rr[1])); } \
        if (__any(rm_ > (float)THR)) { const float mnew = FA_BF16R(mrow + fmaxf(rm_, 0.f)); const float delta = mnew - mrow; const float alpha = __builtin_amdgcn_exp2f(-delta); mrow = mnew; FA_SETQX(); l0 *= alpha; l1 *= alpha; l2 *= alpha; l3 *= alpha; \
            _Pragma("unroll") for (int r = 0; r < 16; ++r) { P0[r] -= delta; P1[r] -= delta; } \
            if (hi == 0) wsf[r32] = alpha; asm volatile("s_waitcnt lgkmcnt(0)" ::: "memory"); \
            _Pragma("unroll") for (int r = 0; r < 16; ++r) { const float f = wsf[crow(r, hi)]; _Pragma("unroll") for (int d0 = 0; d0 < NDB; ++d0) o[d0][r] *= f; } } } while (0)
    constexpr int NG = DQK / 8, NPV = NDB * 4, KD = 4, VD = 3;
    int slot = 0, slot2 = 2 * SLOT;
    f32x16 sa0, sa1, sb0, sb1;
    { const lds_cptr kpn = kp0;
      sa0 = f32x16{}; sa1 = f32x16{};
#pragma unroll
      for (int d0 = 0; d0 < DQK / 16; ++d0) { sa0 = __builtin_amdgcn_mfma_f32_32x32x16_bf16(FA_KLD(d0 * 2048), qr[d0], sa0, 0, 0, 0); sa1 = __builtin_amdgcn_mfma_f32_32x32x16_bf16(FA_KLD(d0 * 2048 + 512), qr[d0], sa1, 0, 0, 0); }
      FA_MASK(sa0, sa1, 0);
      float rma = fmaxf(sa0[0], sa1[0]);
#pragma unroll
      for (int r = 1; r < 16; ++r) rma = fmaxf(rma, fmaxf(sa0[r], sa1[r]));
      { auto rr = __builtin_amdgcn_permlane32_swap(__float_as_uint(rma), __float_as_uint(rma), false, false); rma = fmaxf(__uint_as_float(rr[0]), __uint_as_float(rr[1])); }
      mrow = FA_BF16R(rma); FA_SETQX();
#pragma unroll
      for (int r = 0; r < 16; ++r) { sa0[r] -= mrow; sa1[r] -= mrow; } }
    auto step = [&](auto hn, f32x16& pc0, f32x16& pc1, f32x16& pn0, f32x16& pn1, const int t) __attribute__((always_inline)) {
        constexpr bool HN = decltype(hn)::value;
        if (t + 2 < NT) MLA_DMA(t + 2, slot2);
        const lds_cptr kpn = kp0 + ((slot == 2 * SLOT) ? 0 : slot + SLOT);
        bf16x8 pa[4];
        FA_SB();
        FA_BLOCK_A(HN);
        if (HN) FA_MASK(pn0, pn1, t + 1);
        const lds_cptr vp = vp0 + slot;
        float rma = -INFINITY, rmb = -INFINITY;
        FA_SB();
        s16x4 vlo[VD], vhh[VD];
#pragma unroll
        for (int i = 0; i < VD; ++i) { vlo[i] = vtr(vp + (i >> 2) * 4096 + (i & 3) * 1024); vhh[i] = vtr(vp + (i >> 2) * 4096 + (i & 3) * 1024 + 512); }
#pragma unroll
        for (int i = 0; i < NPV; ++i) { const int d0 = i >> 2, ks = i & 3;
            const bf16x8 vf = (bf16x8){vlo[i % VD][0], vlo[i % VD][1], vlo[i % VD][2], vlo[i % VD][3], vhh[i % VD][0], vhh[i % VD][1], vhh[i % VD][2], vhh[i % VD][3]};
            if (i + VD < NPV) { const int d1 = (i + VD) >> 2, k1 = (i + VD) & 3; vlo[i % VD] = vtr(vp + d1 * 4096 + k1 * 1024); vhh[i % VD] = vtr(vp + d1 * 4096 + k1 * 1024 + 512); }
            o[d0] = __builtin_amdgcn_mfma_f32_32x32x16_bf16(pa[ks], vf, o[d0], 0, 0, 0);
            if (HN && i < 8) { rma = fmaxf(rma, fmaxf(pn0[2 * i], pn1[2 * i])); rmb = fmaxf(rmb, fmaxf(pn0[2 * i + 1], pn1[2 * i + 1])); FA_PIN(rma); FA_PIN(rmb); }
            FA_SB();
        }
        if (HN) FA_DECIDE(fmaxf(rma, rmb), pn0, pn1);
        MLA_WAIT_BAR();
        slot2 = slot; slot = (slot == 2 * SLOT) ? 0 : slot + SLOT;
    };
    const bool skip2 = C::CAUSAL && wid < 4; const int NTw = skip2 ? NT - 2 : NT;
    for (int t = 0; t < NTw; t += 2) {
        step(TagT{}, sa0, sa1, sb0, sb1, t);
        if (t + 2 < NTw) step(TagT{}, sb0, sb1, sa0, sa1, t + 1); else step(TagF{}, sb0, sb1, sa0, sa1, t + 1);
    }
    if (skip2) { MLA_WAIT_BAR(); MLA_WAIT_BAR(); }
    if (issue_next) { MLA_DMA(0, 0); MLA_DMA(1, SLOT); }
    const float lsum_ = (l0 + l1) + (l2 + l3);
#undef FA_ADD
#undef FA_PIN
#undef FA_BLOCK_A
#undef FA_SB
#undef FA_KLD
#undef FA_MASK
#undef FA_DECIDE
#undef FA_BF16R
#undef FA_SETQX
    float lsum = lsum_;
    { auto rr = __builtin_amdgcn_permlane32_swap(__float_as_uint(lsum), __float_as_uint(lsum), false, false); lsum = __uint_as_float(rr[0]) + __uint_as_float(rr[1]); }
    if (hi == 0) wsf[32 + r32] = lsum;
    asm volatile("s_waitcnt lgkmcnt(0)" ::: "memory");
    float rli[16];
#pragma unroll
    for (int r = 0; r < 16; ++r) rli[r] = __builtin_amdgcn_rcpf(wsf[32 + crow(r, hi)]);
    bf16_t* Ow = O + (q_row0 + wid * 32) * OP + h * C::OHS;
    { LAS bf16_t* stg = (LAS bf16_t*)(L + LDS_OST) + wid * (32 * DV);
#pragma unroll
      for (int r = 0; r < 16; ++r) { const int orow = crow(r, hi);
#pragma unroll
          for (int d0 = 0; d0 < NDB; ++d0) stg[orow * DV + d0 * 32 + r32] = (bf16_t)f2bf(o[d0][r] * rli[r]); }
      asm volatile("s_waitcnt lgkmcnt(0)" ::: "memory");
      constexpr int CPR = DV / 8;
#pragma unroll
      for (int i = 0; i < 32 * CPR / 64; ++i) { const int row = i * (64 / CPR) + lane / CPR, ch = lane % CPR; const u32x4 v = *(const LAS u32x4*)(stg + row * DV + ch * 8); *(u32x4*)(Ow + (long)row * OP + ch * 8) = v; } }
    asm volatile("s_waitcnt lgkmcnt(0)\n\ts_barrier" ::: "memory");
#undef MLA_DMA
#undef MLA_WAIT_KEEP
}
template <int THR> __device__ __forceinline__ void mla_phase(const bf16_t* Q, const bf16_t* K, const bf16_t* V, bf16_t* O, const float* qgain, const float* rope, LAS unsigned char* L, int G, int bid) {
    if (G == 256) {
        const int vcu = (bid % 8) * (G / 8) + bid / 8, s = vcu & 7, bh = vcu >> 3;
        for (int i = 0; i < 4; ++i) { const int qb = (i == 0) ? s : (i == 1) ? 15 - s : (i == 2) ? 16 + s : 31 - s; const long rb = (long)(bh / 8) * SEQ;
            unit<CfgMLA, THR>(rb + qb * 256, rb, bh % 8, 4 * qb + 4, Q, K, V, O, L, qgain, SC_MLA, rope, i > 0, i < 3); }
    } else {
        for (int u = bid; u < BATCH * 8 * 32; u += G) { const long rb = (long)(u / 256) * SEQ; const int qb = u % 32; unit<CfgMLA, THR>(rb + qb * 256, rb, (u / 32) % 8, 4 * qb + 4, Q, K, V, O, L, qgain, SC_MLA, rope); }
    }
}
template <int THR> __device__ __forceinline__ void cross_phase(const bf16_t* Q, const bf16_t* K, const bf16_t* V, bf16_t* O, const float* qgain, LAS unsigned char* L, int G, int bid) {
    for (int u = bid; u < BATCH * 4 * 32; u += G) { const int b = u / 128, h = (u / 32) % 4, qb = u % 32;
        unit<CfgCross, THR>((long)b * SEQ + qb * 256, (long)b * NMEM, h, NMEM / 64, Q, K, V, O, L, qgain, SC_MEM); }
}
}


namespace idx {
typedef short bf16x8 __attribute__((ext_vector_type(8)));
typedef float f32x16 __attribute__((ext_vector_type(16)));
typedef __attribute__((address_space(3))) const char* lds_cptr;
constexpr int STG = 8192;
constexpr int LDS_HIST = 3 * STG;
constexpr size_t SCR_WAVE_U32 = 8 * 4096;
__device__ __forceinline__ void glds16(const void* g, unsigned lds_dst) { unsigned sv;
    asm volatile("s_mov_b32 %0, m0\n\ts_mov_b32 m0, %2\n\ts_nop 0\n\tglobal_load_lds_dwordx4 %1, off\n\ts_mov_b32 m0, %0" : "=&s"(sv) : "v"(g), "s"(lds_dst) : "memory"); }
#define IDX_WAIT_BAR() asm volatile("s_waitcnt vmcnt(0) lgkmcnt(0)\n\ts_barrier" ::: "memory")
__device__ __forceinline__ unsigned keypair(float a, float b) {
    const auto h = __builtin_amdgcn_cvt_pkrtz(a, b); const unsigned w = __builtin_bit_cast(unsigned, h);
    const unsigned s = (w >> 15) & 0x00010001u; return w ^ ((s * 0xFFFFu) | 0x80008000u);
}
constexpr int NCOPY = 8, CSTR = 328;
__device__ __forceinline__ unsigned wave_prefix_incl(unsigned v) {
    v += (unsigned)__builtin_amdgcn_update_dpp(0, (int)v, 0x111, 0xF, 0xF, true);
    v += (unsigned)__builtin_amdgcn_update_dpp(0, (int)v, 0x112, 0xF, 0xF, true);
    v += (unsigned)__builtin_amdgcn_update_dpp(0, (int)v, 0x114, 0xF, 0xF, true);
    v += (unsigned)__builtin_amdgcn_update_dpp(0, (int)v, 0x118, 0xF, 0xF, true);
    v += (unsigned)__builtin_amdgcn_update_dpp(0, (int)v, 0x142, 0xA, 0xF, false);
    v += (unsigned)__builtin_amdgcn_update_dpp(0, (int)v, 0x143, 0xC, 0xF, false);
    return v;
}
__device__ __forceinline__ void find_bin(LAS unsigned* hist, unsigned target, int lane, unsigned& bin, unsigned& above_out) {
    u32x4 c = *(LAS u32x4*)(hist + 4 * lane);
#pragma unroll
    for (int k = 1; k < NCOPY; ++k) { const u32x4 d = *(LAS u32x4*)(hist + CSTR * k + 4 * lane); c.x += d.x; c.y += d.y; c.z += d.z; c.w += d.w; }
    const unsigned s = c.x + c.y + c.z + c.w;
    const unsigned pre = wave_prefix_incl(s), total = (unsigned)__builtin_amdgcn_readlane((int)pre, 63), suf = total - pre + s;
    const unsigned long long mk = __ballot(suf >= target);
    const int src = 63 - __builtin_clzll(mk);
    const unsigned above = (unsigned)__builtin_amdgcn_readlane((int)(suf - s), src);
    unsigned cum = above, bsel, ab;
    if (cum + c.w >= target) { bsel = 3; ab = cum; } else { cum += c.w;
        if (cum + c.z >= target) { bsel = 2; ab = cum; } else { cum += c.z;
            if (cum + c.y >= target) { bsel = 1; ab = cum; } else { cum += c.y; bsel = 0; ab = cum; } } }
    bin = (unsigned)__builtin_amdgcn_readlane((int)(4 * lane + bsel), src); above_out = (unsigned)__builtin_amdgcn_readlane((int)ab, src);
}
__device__ __forceinline__ unsigned mbcnt64(unsigned long long m) { return __builtin_amdgcn_mbcnt_hi((unsigned)(m >> 32), __builtin_amdgcn_mbcnt_lo((unsigned)m, 0u)); }
template <int NW> __device__ __forceinline__ void load_row(unsigned (&wr)[NW], const unsigned* srow, int nw32, int lane) {
    { const __amdgpu_buffer_rsrc_t rs = __builtin_amdgcn_make_buffer_rsrc((void*)srow, (short)0, nw32 * 4, 0x00020000);
      int off = lane * 4; asm volatile("" : "+v"(off));
#pragma unroll
      for (int v = 0; v < NW; ++v) wr[v] = __builtin_amdgcn_raw_buffer_load_b32(rs, off, 256 * v, 0); }
}
template <int NW> __device__ __forceinline__ void process_row(const unsigned (&wr)[NW], unsigned short* gout, LAS unsigned* hist, LAS unsigned short* out, int lane) {
    LAS unsigned* hc = hist + CSTR * (lane & (NCOPY - 1));
    LAS unsigned* dmy = hist + 256 + lane;
#pragma unroll
    for (int k = 0; k < NCOPY; ++k) *(LAS u32x4*)(hist + CSTR * k + 4 * lane) = (u32x4){0u, 0u, 0u, 0u};
    asm volatile("s_waitcnt lgkmcnt(0)" ::: "memory");
    { unsigned s8 = 8u, s24 = 24u; asm volatile("" : "+s"(s8), "+s"(s24));
#pragma unroll
      for (int v = 0; v < NW; ++v) { const unsigned w = wr[v];
        __hip_atomic_fetch_add(hc + ((w >> s8) & 0xFFu), 1u, __ATOMIC_RELAXED, __HIP_MEMORY_SCOPE_WORKGROUP);
        __hip_atomic_fetch_add(hc + (w >> s24), 1u, __ATOMIC_RELAXED, __HIP_MEMORY_SCOPE_WORKGROUP); if ((v & 3) == 3) __builtin_amdgcn_sched_barrier(0); } }
    asm volatile("s_waitcnt lgkmcnt(0)" ::: "memory");
    unsigned b1, above1; find_bin(hist, 256u, lane, b1, above1);
    asm volatile("s_waitcnt lgkmcnt(0)" ::: "memory");
#pragma unroll
    for (int k = 0; k < NCOPY; ++k) *(LAS u32x4*)(hist + CSTR * k + 4 * lane) = (u32x4){0u, 0u, 0u, 0u};
    asm volatile("s_waitcnt lgkmcnt(0)" ::: "memory");
#pragma unroll
    for (int v = 0; v < NW; ++v) { const unsigned w = wr[v];
        LAS unsigned* a0 = (((w >> 8) & 0xFFu) == b1) ? hc + (w & 0xFFu) : dmy; LAS unsigned* a1 = ((w >> 24) == b1) ? hc + ((w >> 16) & 0xFFu) : dmy;
        __hip_atomic_fetch_add(a0, 1u, __ATOMIC_RELAXED, __HIP_MEMORY_SCOPE_WORKGROUP);
        __hip_atomic_fetch_add(a1, 1u, __ATOMIC_RELAXED, __HIP_MEMORY_SCOPE_WORKGROUP); if ((v & 3) == 3) __builtin_amdgcn_sched_barrier(0); }
    asm volatile("s_waitcnt lgkmcnt(0)" ::: "memory");
    unsigned b2, above2; find_bin(hist, 256u - above1, lane, b2, above2);
    const unsigned T = (b1 << 8) | b2, T1 = T - 1u, gt_total = above1 + above2;
    unsigned mg[NW / 16], mq[NW / 16];
#pragma unroll
    for (int gi = 0; gi < NW / 16; ++gi) { unsigned a = 0u, e = 0u;
#pragma unroll
        for (int vv = 0; vv < 16; ++vv) { const unsigned w = wr[16 * gi + vv]; const unsigned klo = w & 0xFFFFu, khi = w >> 16;
            a = __builtin_amdgcn_alignbit(a, T - klo, 31); e = __builtin_amdgcn_alignbit(e, T1 - klo, 31);
            a = __builtin_amdgcn_alignbit(a, T - khi, 31); e = __builtin_amdgcn_alignbit(e, T1 - khi, 31); }
        mg[gi] = a; mq[gi] = e & ~a; }
    unsigned base_gt = 0u;
#pragma unroll
    for (int gi = 0; gi < NW / 16; ++gi) { unsigned m = mg[gi];
        for (;;) { const unsigned long long act = __ballot(m != 0u); if (!act) break;
            if (m != 0u) { const int bpos = 31 - __builtin_clz(m), j = 31 - bpos; m &= ~(1u << bpos);
                out[base_gt + mbcnt64(act)] = (unsigned short)(2 * (64 * (16 * gi + (j >> 1)) + lane) + (j & 1)); }
            base_gt += (unsigned)__popcll(act); } }
    unsigned base_eq = gt_total;
#pragma unroll
    for (int gi = 0; gi < NW / 16; ++gi) { unsigned m = mq[gi];
        for (;;) { if (base_eq >= 256u) break; const unsigned long long act = __ballot(m != 0u); if (!act) break;
            if (m != 0u) { const int bpos = 31 - __builtin_clz(m), j = 31 - bpos; m &= ~(1u << bpos); const unsigned e = base_eq + mbcnt64(act);
                if (e < 256u) out[e] = (unsigned short)(2 * (64 * (16 * gi + (j >> 1)) + lane) + (j & 1)); }
            base_eq += (unsigned)__popcll(act); } }
    asm volatile("s_waitcnt lgkmcnt(0)" ::: "memory");
    *(u32x2*)(gout + 4 * lane) = *(LAS u32x2*)(out + 4 * lane);
}
template <int NW> __device__ __forceinline__ void select8(const unsigned* scr, int nw32, unsigned short* sel0, LAS unsigned* hist, LAS unsigned short* sbuf, int lane) {
    unsigned wa[NW], wb[NW];
    load_row<NW>(wa, scr, nw32, lane);
#pragma unroll 1
    for (int i = 0; i < 8; i += 2) {
        load_row<NW>(wb, scr + (size_t)(i + 1) * 4096, nw32, lane);
        process_row<NW>(wa, sel0 + (size_t)i * 256, hist, sbuf, lane);
        if (i + 2 < 8) load_row<NW>(wa, scr + (size_t)(i + 2) * 4096, nw32, lane);
        process_row<NW>(wb, sel0 + (size_t)(i + 1) * 256, hist, sbuf, lane);
    }
}
__device__ __forceinline__ void unit(int b, int ub, const bf16_t* proj, const bf16_t* Ki, const float* Wi, unsigned short* SEL, unsigned* scr, LAS unsigned char* L) {
    const int tid = tid_opaque(), lane = tid & 63, n32 = lane & 31, hb = lane >> 5; const int wid = __builtin_amdgcn_readfirstlane(tid >> 6);
    const long rowb = (long)b * SEQ; const int t0w = 64 * ub + 8 * wid;
    const int hbm = (n32 >> 2) & 1, rr = (n32 & 3) + 4 * (n32 >> 3), qq = 2 * hbm + (rr >> 3), hh = rr & 7;
    bf16x8 af[2][4];
#pragma unroll
    for (int ta = 0; ta < 2; ++ta) { const bf16_t* qp = proj + (rowb + t0w + 4 * ta + qq) * PP + C_QI + hh * 64 + hb * 8;
#pragma unroll
        for (int kk = 0; kk < 4; ++kk) af[ta][kk] = *reinterpret_cast<const bf16x8*>(qp + 16 * kk); }
    f32x4 wq[2][2][2];
#pragma unroll
    for (int ta = 0; ta < 2; ++ta)
#pragma unroll
        for (int j = 0; j < 2; ++j) { const float* wp = Wi + (rowb + t0w + 4 * ta + 2 * hb + j) * 8; wq[ta][j][0] = *(const f32x4*)wp; wq[ta][j][1] = *(const f32x4*)(wp + 4); }
    const unsigned lds0 = (unsigned)(uintptr_t)L;
    const bf16_t* ksrc = Ki + (rowb + 2 * n32 + hb) * 64 + wid * 8;
    const unsigned kdst = lds0 + wid * 1024;
    const lds_cptr bp0 = (lds_cptr)L + hb * 1024 + n32 * 16;
    const int nst = ub + 1;
    unsigned* srow_w = scr + (size_t)(2 * hb) * 4096 + n32;
    glds16(ksrc, (unsigned)__builtin_amdgcn_readfirstlane(kdst));
    if (nst > 1) glds16(ksrc + (size_t)64 * 64, (unsigned)__builtin_amdgcn_readfirstlane(kdst + STG));
    if (nst > 1) asm volatile("s_waitcnt vmcnt(1) lgkmcnt(0)\n\ts_barrier" ::: "memory"); else IDX_WAIT_BAR();
#define IX_PIN(x) asm volatile("" : "+v"(x))
#define IX_SB() __builtin_amdgcn_sched_barrier(0)
#define IX_SLICE(SC, ACC, c, hq) do { const int ta_ = (c) >> 1, j_ = (c) & 1; float t0_, t1_, t2_, t3_; asm("v_max_f32 %1, 0, %5\n\tv_max_f32 %2, 0, %6\n\tv_fmac_f32 %0, %9, %1\n\tv_max_f32 %3, 0, %7\n\tv_fmac_f32 %0, %10, %2\n\tv_max_f32 %4, 0, %8\n\tv_fmac_f32 %0, %11, %3\n\tv_fmac_f32 %0, %12, %4" : "+v"(SC[c]), "=&v"(t0_), "=&v"(t1_), "=&v"(t2_), "=&v"(t3_) : "v"(ACC[ta_][8 * j_ + 4 * (hq) + 0]), "v"(ACC[ta_][8 * j_ + 4 * (hq) + 1]), "v"(ACC[ta_][8 * j_ + 4 * (hq) + 2]), "v"(ACC[ta_][8 * j_ + 4 * (hq) + 3]), "v"(wq[ta_][j_][hq][0]), "v"(wq[ta_][j_][hq][1]), "v"(wq[ta_][j_][hq][2]), "v"(wq[ta_][j_][hq][3])); IX_PIN(SC[c]); } while (0)
    unsigned res[4] = {0u, 0u, 0u, 0u};
    f32x16 accA[2], accB[2]; float scA[4] = {0.f, 0.f, 0.f, 0.f}, scB[4] = {0.f, 0.f, 0.f, 0.f};
    accB[0] = f32x16{}; accB[1] = f32x16{};
    int buf = 0, buf2 = 2 * STG;
    for (int st = 0; st < nst; ++st) {
        if (st + 2 < nst) glds16(ksrc + (size_t)(st + 2) * 64 * 64, (unsigned)__builtin_amdgcn_readfirstlane(kdst + buf2));
        bf16x8 bfr[4], bfs[4];
#pragma unroll
        for (int kk = 0; kk < 4; ++kk) bfr[kk] = *(const __attribute__((address_space(3))) bf16x8*)(bp0 + buf + kk * 2048);
#pragma unroll
        for (int kk = 0; kk < 4; ++kk) bfs[kk] = *(const __attribute__((address_space(3))) bf16x8*)(bp0 + buf + kk * 2048 + 512);
#pragma unroll
        for (int c = 0; c < 4; ++c) scB[c] = 0.f;
        IX_SB();
#pragma unroll
        for (int i = 0; i < 8; ++i) { const int ta = i >> 2, kk = i & 3;
            accA[ta] = __builtin_amdgcn_mfma_f32_32x32x16_bf16(af[ta][kk], bfr[kk], kk == 0 ? f32x16{} : accA[ta], 0, 0, 0);
            IX_SLICE(scB, accB, i >> 1, i & 1);
            IX_SB(); }
        if (st > 0) {
#pragma unroll
            for (int c = 0; c < 4; ++c) { res[c] = keypair(scA[c], scB[c]); srow_w[(size_t)(4 * (c >> 1) + (c & 1)) * 4096 + 32 * (st - 1)] = res[c]; }
        }
#pragma unroll
        for (int c = 0; c < 4; ++c) scA[c] = 0.f;
        IX_SB();
#pragma unroll
        for (int i = 0; i < 8; ++i) { const int ta = i >> 2, kk = i & 3;
            accB[ta] = __builtin_amdgcn_mfma_f32_32x32x16_bf16(af[ta][kk], bfs[kk], kk == 0 ? f32x16{} : accB[ta], 0, 0, 0);
            IX_SLICE(scA, accA, i >> 1, i & 1);
            IX_SB(); }
        { const bool ks = st > 0, kd = st + 2 < nst;
          if (st >= 2 && kd) asm volatile("s_waitcnt vmcnt(9) lgkmcnt(0)\n\ts_barrier" ::: "memory");
          else if (st >= 2) asm volatile("s_waitcnt vmcnt(8) lgkmcnt(0)\n\ts_barrier" ::: "memory");
          else if (ks) asm volatile("s_waitcnt vmcnt(4) lgkmcnt(0)\n\ts_barrier" ::: "memory");
          else IDX_WAIT_BAR(); }
        buf2 = buf; buf = (buf == 2 * STG) ? 0 : buf + STG;
    }
#pragma unroll
    for (int c = 0; c < 4; ++c) { scB[c] = 0.f; IX_SLICE(scB, accB, c, 0); IX_SLICE(scB, accB, c, 1); }
#pragma unroll
    for (int ta = 0; ta < 2; ++ta)
#pragma unroll
        for (int j = 0; j < 2; ++j) { unsigned rv = keypair(scA[ta * 2 + j], scB[ta * 2 + j]); const int t = t0w + 4 * ta + 2 * hb + j, k0 = 64 * (nst - 1) + 2 * n32;
            if (k0 > t) rv &= 0xFFFF0000u; if (k0 + 1 > t) rv &= 0x0000FFFFu;
            srow_w[(size_t)(4 * ta + j) * 4096 + 32 * (nst - 1)] = rv; }
#undef IX_PIN
#undef IX_SB
#undef IX_SLICE
    asm volatile("s_waitcnt vmcnt(0)" ::: "memory");
    LAS unsigned* hist = (LAS unsigned*)(L + LDS_HIST) + wid * (NCOPY * CSTR); LAS unsigned short* sbufw = (LAS unsigned short*)(L + LDS_HIST + 8 * NCOPY * CSTR * 4) + wid * 256;
    { unsigned short* sel0 = SEL + (size_t)(rowb + t0w) * 256;
      if (t0w + 8 <= 256) {
#pragma unroll 1
          for (int i = 0; i < 8; ++i) { const int n = t0w + i + 1;
#pragma unroll
              for (int j = 0; j < 4; ++j) { const int k = lane + 64 * j; sel0[(size_t)i * 256 + k] = k < n ? (unsigned short)k : (unsigned short)0xFFFFu; } }
      } else if (t0w + 8 <= 2048) select8<16>(scr, 32 * nst, sel0, hist, sbufw, lane);
      else if (t0w + 8 <= 4096) select8<32>(scr, 32 * nst, sel0, hist, sbufw, lane);
      else if (t0w + 8 <= 6144) select8<48>(scr, 32 * nst, sel0, hist, sbufw, lane);
      else select8<64>(scr, 32 * nst, sel0, hist, sbufw, lane); }
}
__device__ __forceinline__ void phase(const bf16_t* proj, const bf16_t* Ki, const float* Wi, unsigned short* SEL, unsigned* scrA, unsigned* scrB, LAS unsigned char* L, int G, int bid, int wave) {
    const int gwv = bid * 8 + wave;
    unsigned* scr = (gwv < 1024 ? scrA + (size_t)gwv * SCR_WAVE_U32 : scrB + (size_t)(gwv - 1024) * SCR_WAVE_U32);
    if (G == 256) {
        const int b = (bid & 7) >> 1, j = (bid >> 3) * 2 + (bid & 1);
        unit(b, 127 - j, proj, Ki, Wi, SEL, scr, L);
        unit(b, j, proj, Ki, Wi, SEL, scr, L);
    } else {
        for (int u = bid; u < BATCH * 128; u += G) unit(u >> 7, u & 127, proj, Ki, Wi, SEL, scr, L);
    }
    asm volatile("s_waitcnt vmcnt(0) lgkmcnt(0)\n\ts_barrier" ::: "memory");
}
}


namespace sparse {
typedef short bf16x8 __attribute__((ext_vector_type(8)));
typedef short s16x4 __attribute__((ext_vector_type(4)));
typedef __attribute__((address_space(3))) const char* lds_cptr;
__device__ __forceinline__ void glds16(const void* g, unsigned lds_dst) { unsigned sv;
    asm volatile("s_mov_b32 %0, m0\n\ts_mov_b32 m0, %2\n\ts_nop 0\n\tglobal_load_lds_dwordx4 %1, off\n\ts_mov_b32 m0, %0" : "=&s"(sv) : "v"(g), "s"(lds_dst) : "memory"); }
__device__ __forceinline__ void glds16_so(const void* sbase, unsigned voff, unsigned lds_dst) { unsigned sv;
    asm volatile("s_mov_b32 %0, m0\n\ts_mov_b32 m0, %3\n\ts_nop 0\n\tglobal_load_lds_dwordx4 %1, %2\n\ts_mov_b32 m0, %0" : "=&s"(sv) : "v"(voff), "s"(sbase), "s"(lds_dst) : "memory"); }
__device__ __forceinline__ float xmax16(float v) { auto r = __builtin_amdgcn_permlane16_swap(__float_as_uint(v), __float_as_uint(v), false, false); return fmaxf(__uint_as_float(r[0]), __uint_as_float(r[1])); }
__device__ __forceinline__ float xmax32(float v) { auto r = __builtin_amdgcn_permlane32_swap(__float_as_uint(v), __float_as_uint(v), false, false); return fmaxf(__uint_as_float(r[0]), __uint_as_float(r[1])); }
__device__ __forceinline__ float xsum16(float v) { auto r = __builtin_amdgcn_permlane16_swap(__float_as_uint(v), __float_as_uint(v), false, false); return __uint_as_float(r[0]) + __uint_as_float(r[1]); }
__device__ __forceinline__ float xsum32(float v) { auto r = __builtin_amdgcn_permlane32_swap(__float_as_uint(v), __float_as_uint(v), false, false); return __uint_as_float(r[0]) + __uint_as_float(r[1]); }
__device__ __forceinline__ s16x4 vtr(lds_cptr p) { typedef short v4i16_t __attribute__((ext_vector_type(4))); return __builtin_bit_cast(s16x4, __builtin_amdgcn_ds_read_tr16_b64_v4i16((__attribute__((address_space(3))) v4i16_t*)p)); }
__device__ __forceinline__ unsigned cvtpk(float lo, float hi) { typedef float f2 __attribute__((ext_vector_type(2))); typedef __bf16 b2 __attribute__((ext_vector_type(2))); f2 v = {lo, hi}; b2 b = __builtin_convertvector(v, b2); return __builtin_bit_cast(unsigned, b); }

__device__ __forceinline__ void query(int row, const bf16_t* proj, const bf16_t* kvd, const unsigned short* SEL, bf16_t* mix, LAS unsigned char* Lw, int lane) {
    const int b = row / SEQ, t = row % SEQ, n16 = lane & 15, kq = lane >> 4, h32 = lane >> 5, pos = lane & 31;
    const int nvalid = (t + 1) < 256 ? (t + 1) : 256;
    const unsigned lds0 = (unsigned)(uintptr_t)Lw;
    bf16x8 qf[2][2];
#pragma unroll
    for (int g = 0; g < 2; ++g)
#pragma unroll
        for (int ks = 0; ks < 2; ++ks) { qf[g][ks] = (bf16x8){0, 0, 0, 0, 0, 0, 0, 0};
            if (n16 < 4) qf[g][ks] = *reinterpret_cast<const bf16x8*>(proj + (size_t)row * PP + C_QD + (4 * g + n16) * 64 + 32 * ks + 8 * kq); }
    const unsigned short* selr = SEL + (size_t)row * 256;
    const bf16_t* kvb = kvd + (size_t)b * SEQ * 256;
    float mrun[2] = {-INFINITY, -INFINITY}, lsum[2] = {0.f, 0.f};
    f32x4 o[2][4];
#pragma unroll
    for (int g = 0; g < 2; ++g)
#pragma unroll
        for (int nt = 0; nt < 4; ++nt) o[g][nt] = (f32x4){0.f, 0.f, 0.f, 0.f};
    u32x4 ixr[8];
#pragma unroll
    for (int c = 0; c < 8; ++c) ixr[c] = *(const u32x4*)(selr + 32 * c + 8 * kq);
    const int nch = (nvalid + 31) >> 5;
    if (nvalid < 256) {
#pragma unroll
        for (int c = 0; c < 8; ++c) { unsigned w4[4] = {ixr[c].x, ixr[c].y, ixr[c].z, ixr[c].w};
#pragma unroll
            for (int e = 0; e < 4; ++e) { unsigned lo = w4[e] & 0xFFFFu, hi = w4[e] >> 16; if (lo > (unsigned)t) lo = 0u; if (hi > (unsigned)t) hi = 0u; w4[e] = lo | (hi << 16); }
            ixr[c] = (u32x4){w4[0], w4[1], w4[2], w4[3]}; }
    }
#pragma unroll
    for (int c = 0; c < 8; ++c) asm volatile("" : "+v"(ixr[c]));
#define SP_ISSUE(c_, voff_, ldso_, ISV_) do { const unsigned w_[4] = {ixr[c_].x, ixr[c_].y, ixr[c_].z, ixr[c_].w}; \
        _Pragma("unroll") for (int i = 0; i < 8; ++i) { unsigned idx = (i & 1) ? (w_[i >> 1] >> 16) : (w_[i >> 1] & 0xFFFFu); \
            const int r = 4 * i + kq; const int lp = (ISV_) ? (n16 ^ (2 * (r & 7))) : (n16 ^ (r & 15)); \
            glds16_so(kvb, idx * 512u + (unsigned)((voff_) + lp * 16), (unsigned)__builtin_amdgcn_readfirstlane(lds0 + (ldso_) + i * 1024)); } } while (0)
    SP_ISSUE(0, 0, 0, false); SP_ISSUE(0, 256, 8192, true);
    const lds_cptr base = (lds_cptr)Lw;
#pragma unroll
    for (int c = 0; c < 8; ++c) {
        if (c < nch) {
            const bool more = c + 1 < nch;
            asm volatile("s_waitcnt vmcnt(8)" ::: "memory");
            bf16x8 kf[2][2][2];
#pragma unroll
            for (int g = 0; g < 2; ++g)
#pragma unroll
                for (int mt = 0; mt < 2; ++mt)
#pragma unroll
                    for (int ks = 0; ks < 2; ++ks) { const int piece = (g * 8 + ks * 4 + kq) ^ n16;
                        kf[g][mt][ks] = *(const __attribute__((address_space(3))) bf16x8*)(base + (16 * mt + n16) * 256 + piece * 16); }
            asm volatile("s_waitcnt lgkmcnt(0)" ::: "memory");
            if (more) { if (c + 1 < 8) SP_ISSUE(c + 1 < 8 ? c + 1 : 7, 0, 0, false); }
            bf16x8 pa[2];
#pragma unroll
            for (int g = 0; g < 2; ++g) {
                f32x4 sacc[2];
#pragma unroll
                for (int mt = 0; mt < 2; ++mt) { f32x4 a = (f32x4){0.f, 0.f, 0.f, 0.f};
#pragma unroll
                    for (int ks = 0; ks < 2; ++ks) a = __builtin_amdgcn_mfma_f32_16x16x32_bf16(kf[g][mt][ks], qf[g][ks], a, 0, 0, 0);
                    sacc[mt] = a; }
                if (32 * c + 32 > nvalid) {
#pragma unroll
                    for (int mt = 0; mt < 2; ++mt)
#pragma unroll
                        for (int i = 0; i < 4; ++i) { const int kp = 8 * i + 4 * mt + kq; if (32 * c + kp >= nvalid) sacc[mt][i] = -INFINITY; }
                }
                float cm = fmaxf(fmaxf(fmaxf(sacc[0][0], sacc[0][1]), fmaxf(sacc[0][2], sacc[0][3])), fmaxf(fmaxf(sacc[1][0], sacc[1][1]), fmaxf(sacc[1][2], sacc[1][3])));
                cm = xmax16(cm); cm = xmax32(cm);
                if (__any(cm > mrun[g] + 8.0f)) {
                    const float mnew = fmaxf(mrun[g], cm);
                    const float alpha = __builtin_amdgcn_exp2f(mrun[g] - mnew);
                    mrun[g] = mnew; lsum[g] *= alpha;
#pragma unroll
                    for (int i = 0; i < 4; ++i) { const float f = __shfl(alpha, 4 * kq + i);
#pragma unroll
                        for (int nt = 0; nt < 4; ++nt) o[g][nt][i] *= f; }
                }
                const float mref = mrun[g];
                float p0[4], p1[4], ps = 0.f;
#pragma unroll
                for (int i = 0; i < 4; ++i) { p0[i] = __builtin_amdgcn_exp2f(sacc[0][i] - mref); p1[i] = __builtin_amdgcn_exp2f(sacc[1][i] - mref); ps += p0[i] + p1[i]; }
                lsum[g] += ps;
                typedef unsigned u4 __attribute__((ext_vector_type(4)));
                u4 pw; pw.x = cvtpk(p0[0], p0[1]); pw.y = cvtpk(p0[2], p0[3]); pw.z = cvtpk(p1[0], p1[1]); pw.w = cvtpk(p1[2], p1[3]);
                pa[g] = __builtin_bit_cast(bf16x8, pw);
            }
            if (more) asm volatile("s_waitcnt vmcnt(8)" ::: "memory"); else asm volatile("s_waitcnt vmcnt(0)" ::: "memory");
            const int qp = n16 >> 2, pp = n16 & 3;
#pragma unroll
            for (int g = 0; g < 2; ++g)
#pragma unroll
                for (int nt = 0; nt < 4; ++nt) {
                    const int r0 = 4 * kq + qp, r1 = r0 + 16, cv = g * 8 + 2 * nt + (pp >> 1);
                    const s16x4 lo = vtr(base + 8192 + r0 * 256 + ((cv ^ (2 * (r0 & 7))) * 16) + (pp & 1) * 8);
                    const s16x4 hi = vtr(base + 8192 + r1 * 256 + ((cv ^ (2 * (r1 & 7))) * 16) + (pp & 1) * 8);
                    const bf16x8 vf = (bf16x8){lo[0], lo[1], lo[2], lo[3], hi[0], hi[1], hi[2], hi[3]};
                    o[g][nt] = __builtin_amdgcn_mfma_f32_16x16x32_bf16(pa[g], vf, o[g][nt], 0, 0, 0);
                }
            asm volatile("s_waitcnt lgkmcnt(0)" ::: "memory");
            if (more) { if (c + 1 < 8) SP_ISSUE(c + 1 < 8 ? c + 1 : 7, 256, 8192, true); }
        }
    }
#undef SP_ISSUE
#pragma unroll
    for (int g = 0; g < 2; ++g) {
        float l = lsum[g]; l = xsum16(l); l = xsum32(l);
        float il[4];
#pragma unroll
        for (int i = 0; i < 4; ++i) il[i] = 1.0f / __shfl(l, i);
        if (kq == 0) {
            bf16_t* op = mix + (size_t)row * 1024 + 512 + (4 * g) * 64 + n16;
#pragma unroll
            for (int i = 0; i < 4; ++i)
#pragma unroll
                for (int nt = 0; nt < 4; ++nt) op[i * 64 + 16 * nt] = (bf16_t)f2bf(o[g][nt][i] * il[i]);
        }
    }
}
__device__ __forceinline__ void phase(const bf16_t* proj, const bf16_t* kvd, const unsigned short* SEL, bf16_t* mix, LAS unsigned char* L, int G, int bid, int wave, int lane) {
    LAS unsigned char* Lw = L + wave * 16384;
    if (G == 256) {
        const int b = (bid & 7) >> 1, wb = ((bid >> 3) * 2 + (bid & 1)) * 8 + wave;
        for (int t = wb; t < SEQ; t += 512) query(b * SEQ + t, proj, kvd, SEL, mix, Lw, lane);
    } else {
        for (int row = bid * 8 + wave; row < M; row += G * 8) query(row, proj, kvd, SEL, mix, Lw, lane);
    }
}
}


__device__ __forceinline__ unsigned char* ws_at(unsigned char* ws, size_t off) { unsigned long long q = (unsigned long long)(ws + off); asm volatile("" : "+s"(q)); return AS_GLOBAL(unsigned char*, q); }
#define GEMM_PHASE(EpiT, Eobj, Aptr, lda_, Bptr, ldb_, M_, N_, K_) GEMM_PHASE_O(EpiT, Eobj, Aptr, lda_, Bptr, ldb_, M_, N_, K_, 0)
#define GEMM_PHASE_O(EpiT, Eobj, Aptr, lda_, Bptr, ldb_, M_, N_, K_, BOFF_) do { \
    int k_rt_ = (K_), lda_rt_ = (lda_), ldb_rt_ = (ldb_), m_rt_ = (M_), n_rt_ = (N_); \
    asm volatile("" : "+s"(k_rt_), "+s"(lda_rt_), "+s"(ldb_rt_), "+s"(m_rt_), "+s"(n_rt_));     \
    pg8::Gemm g_; g_.A = (Aptr); g_.Bt = (Bptr); g_.M = m_rt_; g_.N = n_rt_; g_.K = k_rt_; g_.lda = lda_rt_; g_.ldb = ldb_rt_; g_.pad = 0; \
    pg8::StaticOrder S_; S_.init(m_rt_, n_rt_, G, (bid + (BOFF_)) % G); \
    pg8::gemm_phase<EpiT, pg8::StaticOrder, true, true>(L, g_, S_, (Eobj)); } while (0)

__global__ void __launch_bounds__(NTHREADS, 2) mega_fwd(Params p) {
    extern __shared__ __attribute__((aligned(16))) unsigned char lds[];
    LAS unsigned char* L = (LAS unsigned char*)lds;
    volatile LAS unsigned* MISC = (volatile LAS unsigned*)(L + MISC_OFF);
    const int tid0 = threadIdx.x, wave = __builtin_amdgcn_readfirstlane(tid0 >> 6);
    const int G = gridDim.x, bid = blockIdx.x;
    const int gw = bid * NWAVES + wave, NGW = G * NWAVES;
    if (tid0 < 32) MISC[tid0] = 0u;
    __syncthreads();
    XcdBarrier bar = xcd_barrier_post((unsigned*)(P_WS + WS_CTL) + CW_BAR, MISC + 8);

#define WSB(off) ((bf16_t*)ws_at(P_WS, (off)))
    { const int tid = tid_opaque(), lane = tid & 63; (void)tid; (void)lane;
      ph_weights(L, gw, NGW, wave, lane, true);
    }
    { const int tid = tid_opaque(), lane = tid & 63; (void)tid; (void)lane;
      ph_rope(((const int*)P_IN(2)), ((float*)ws_at(P_WS, WS_ROPE)), bid * NTHREADS + tid, G * NTHREADS);
    }
    { const int tid = tid_opaque(), lane = tid & 63; (void)tid; (void)lane;
      ph_rmsnorm_rows(P_IN(0), P_IN(3), WSB(WS_XN), M, gw, NGW, lane);
    }
    { const int tid = tid_opaque(), lane = tid & 63; (void)tid; (void)lane;
      ph_rmsnorm_rows(P_IN(1), P_IN(16), WSB(WS_MEMN), BATCH * NMEM, gw, NGW, lane);
    }
    { const int tid = tid_opaque(); f32x4* z = (f32x4*)ws_at(P_WS, WS_SSQ1); for (int i = bid * NTHREADS + tid; i < 4 * M / 4; i += G * NTHREADS) z[i] = (f32x4){0.f, 0.f, 0.f, 0.f}; }
    xcd_barrier(bar);
    { EpiProj E; E.pad = 0; GEMM_PHASE(EpiProj, E, WSB(WS_XN), 1024, WSB(WS_WIN), 1024, M, PP, 1024); }
    { pg8::EpiStore E; E.O = WSB(WS_KVC); E.ldc = 1024; E.pad = 0; GEMM_PHASE_O(pg8::EpiStore, E, WSB(WS_MEMN), 1024, WSB(WS_WMKV), 1024, BATCH * NMEM, 1024, 1024, 128); }
    if (G == 256 && bid >= 144) {
        const int tid = tid_opaque(), lane = tid & 63;
        ph_weights(L, (bid - 144) * NWAVES + wave, 112 * NWAVES, wave, lane, false);
    } else if (G != 256) { const int tid = tid_opaque(), lane = tid & 63; ph_weights(L, gw, NGW, wave, lane, false); }
    xcd_barrier(bar);
    { const int tid = tid_opaque(), lane = tid & 63; (void)tid; (void)lane;
      ph_headnorm128(WSB(WS_KVC), BATCH * NMEM, 1024, 0, 4, P_IN(21), 1.0f, gw, NGW, lane);
    }
    { pg8::EpiStoreRS E; E.O = WSB(WS_QM); E.ssq = (const float*)ws_at(P_WS, WS_SSQ_CQ); E.ldc = 768; E.inv_ncols = 1.0f / 256.0f; E.eps = EPS; E.pad = 0; GEMM_PHASE(pg8::EpiStoreRS, E, WSB(WS_PROJ) + C_CQ, PP, WSB(WS_WUQ), 256, M, 768, 256); }
    { EpiKV E; E.pad = 0; GEMM_PHASE(EpiKV, E, WSB(WS_PROJ) + C_CKV, PP, WSB(WS_WUKV), 128, M, 1024, 128); }
    idx::phase(WSB(WS_PROJ), WSB(WS_KI), ((float*)ws_at(P_WS, WS_WI)), ((unsigned short*)ws_at(P_WS, WS_SEL)), (unsigned*)ws_at(P_WS, WS_XN), (unsigned*)P_OUT, L, G, bid, wave);
    xcd_barrier(bar);
    fa2::mla_phase<8>(WSB(WS_QM), WSB(WS_KM), WSB(WS_KVM) + 64, WSB(WS_MIX), P_IN(9), (const float*)ws_at(P_WS, WS_ROPE), L, G, bid);
    { const int tid = tid_opaque(), lane = tid & 63; (void)tid; (void)lane;
      sparse::phase(WSB(WS_PROJ), WSB(WS_KVD), (const unsigned short*)ws_at(P_WS, WS_SEL), WSB(WS_MIX), L, G, bid, wave, lane);
    }
    xcd_barrier(bar);
    { pg8::EpiResNorm E; E.base = P_IN(0); E.baseb = nullptr; E.xb = WSB(WS_XN); E.ssq = (float*)ws_at(P_WS, WS_SSQ1); E.ldc = 1024; E.pad = 0; GEMM_PHASE(pg8::EpiResNorm, E, WSB(WS_MIX), 1024, WSB(WS_WOUT), 1024, M, 1024, 1024); }
    xcd_barrier(bar);
    { pg8::EpiStoreRS E; E.O = WSB(WS_QC); E.ssq = (const float*)ws_at(P_WS, WS_SSQ1); E.ldc = 512; E.inv_ncols = 1.0f / 1024.0f; E.eps = EPS; E.pad = 0; GEMM_PHASE(pg8::EpiStoreRS, E, WSB(WS_XN), 1024, WSB(WS_WMQ), 1024, M, 512, 1024); }
    xcd_barrier(bar);
    fa::cross_phase<0>(WSB(WS_QC), WSB(WS_KVC), WSB(WS_KVC) + 512, WSB(WS_QC), P_IN(20), L, G, bid);
    xcd_barrier(bar);
    { pg8::EpiResNorm E; E.base = nullptr; E.baseb = WSB(WS_XN); E.xb = WSB(WS_XN); E.ssq = (float*)ws_at(P_WS, WS_SSQ2); E.ldc = 1024; E.pad = 0; GEMM_PHASE(pg8::EpiResNorm, E, WSB(WS_QC), 512, WSB(WS_WMO), 512, M, 1024, 512); }
    xcd_barrier(bar);
    { pg8::EpiSwiGLURS E; E.H = WSB(WS_H); E.ssq = (const float*)ws_at(P_WS, WS_SSQ2); E.ldh = DFF; E.inv_ncols = 1.0f / 1024.0f; E.eps = EPS; E.pad = 0; GEMM_PHASE(pg8::EpiSwiGLURS, E, WSB(WS_XN), 1024, WSB(WS_WGU), 1024, M, 2 * DFF, 1024); }
    xcd_barrier(bar);
    { pg8::EpiResB16 E; E.baseb = WSB(WS_XN); E.out = P_OUT; E.ldc = 1024; E.pad = 0; GEMM_PHASE(pg8::EpiResB16, E, WSB(WS_H), DFF, WSB(WS_WDN), DFF, M, 1024, DFF); }
}

extern "C" void kernel_launch(void* const* d_in, const int* in_sizes, int n_in, void* d_out, int out_size, void* d_ws, size_t ws_size, hipStream_t stream) {
    static int grid = 0;
    if (grid == 0) {
        if (n_in != 27 || in_sizes[0] != M * DM || out_size != M * DM || ws_size < WS_END) { fprintf(stderr, "kernel_launch: unexpected shapes (n_in %d, in0 %d, out %d, ws %zu)\n", n_in, n_in > 0 ? in_sizes[0] : -1, out_size, ws_size); grid = -1; return; }
        int dev = 0, cus = 0, per_cu = 0;
        if (hipGetDevice(&dev) != hipSuccess || hipDeviceGetAttribute(&cus, hipDeviceAttributeMultiprocessorCount, dev) != hipSuccess) { fprintf(stderr, "kernel_launch: device query failed\n"); grid = -1; return; }
        if (hipFuncSetAttribute((const void*)mega_fwd, hipFuncAttributeMaxDynamicSharedMemorySize, LDS_BYTES) != hipSuccess) { fprintf(stderr, "kernel_launch: hipFuncSetAttribute failed\n"); grid = -1; return; }
        if (hipOccupancyMaxActiveBlocksPerMultiprocessor(&per_cu, (const void*)mega_fwd, NTHREADS, LDS_BYTES) != hipSuccess || per_cu < 1) { fprintf(stderr, "kernel_launch: occupancy query reports %d blocks per CU\n", per_cu); }
        (void)hipGetLastError();
        grid = cus;
    }
    if (grid < 0) return;
    (void)hipMemsetAsync((char*)d_ws + WS_CTL, 0, CTL_ZERO_BYTES, stream);
    Params p{};
    for (int i = 0; i < 27; ++i) p.in[i] = (const float*)d_in[i];
    p.out = (float*)d_out; p.ws = (unsigned char*)d_ws;
    hipLaunchKernelGGL(mega_fwd, dim3(grid), dim3(NTHREADS), LDS_BYTES, stream, p);
}
```

```cpp
#include <hip/hip_runtime.h>
#include <cstdio>
#include <cstdint>
#include <cmath>
__device__ __forceinline__ int tid_opaque() { int t = threadIdx.x; asm volatile("" : "+v"(t)); return t; }
namespace pg8 {
#define PG8_LAS __attribute__((address_space(3)))
typedef unsigned short bf16_t;
typedef short bf16x8 __attribute__((ext_vector_type(8)));
typedef float f32x4 __attribute__((ext_vector_type(4)));
typedef unsigned u32x4 __attribute__((ext_vector_type(4)));
constexpr int BM = 256, BK = 64, HALF = 128, HTB = HALF * BK * 2  , STAGE_BYTES = 8 * HTB, NXCD = 8, WGM = 4;

__host__ __device__ __forceinline__ int lds_byte(int r, int c) { const int st = (r >> 4) * 2 + (c >> 5), rr = r & 15, cc = c & 31, ob = rr * 64 + cc * 2; return st * 1024 + (ob ^ (((ob >> 9) & 1) << 5)); }
__host__ __device__ __forceinline__ void stage_rc(int b, int& R, int& C) { const int st = b / 1024, sb = b % 1024, swz = sb ^ (((sb >> 9) & 1) << 5); R = (st >> 1) * 16 + swz / 64; C = (st & 1) * 32 + (swz % 64) / 2; }
__host__ __device__ __forceinline__ int perm32(int rho) { const int n = rho >> 4, i = rho & 15; return 8 * (i >> 2) + 4 * n + (i & 3); }

struct Unit { int pm, pn; };
struct Gemm { const bf16_t* A; const bf16_t* Bt; int M, N, K, lda, ldb, pad; };

struct StaticOrder {
    int nM, nN, nwg, G, c;
    __host__ __device__ void init(int M, int N, int G_, int c_) { nM = M / BM; nN = N / BM; nwg = nM * nN; G = G_; c = c_; }
    __host__ __device__ bool next(int i, Unit& u) const {
        const long L = (long)i * G + c; if (L >= nwg) return false;
        int wgid = (int)L; { const int q = nwg / NXCD, r = nwg % NXCD, xcd = wgid % NXCD, off = wgid / NXCD; wgid = (xcd < r ? xcd * (q + 1) : r * (q + 1) + (xcd - r) * q) + off; }
        const int nig = WGM * nN, gid = wgid / nig, fm = gid * WGM, gsz = (nM - fm) < WGM ? (nM - fm) : WGM;
        u.pm = fm + ((wgid % nig) % gsz); u.pn = (wgid % nig) / gsz; return true;
    }
    __device__ __forceinline__ void a_ready(const Unit&) const {}
    __device__ __forceinline__ void done(const Unit&) const {}
};

__device__ __forceinline__ unsigned cvt_pk_bf16(float lo, float hi) { unsigned r; asm volatile("v_cvt_pk_bf16_f32 %0, %1, %2" : "=v"(r) : "v"(lo), "v"(hi)); return r; }
struct EpiStore {
    static constexpr bool PERM = true, AFTER_DRAIN = false;
    bf16_t* O; int ldc; int pad;
    __device__ __forceinline__ void operator()(const f32x4 (&acc)[2][2][4][2], const Unit& u, int wr, int wc, int fr, int fq) const {
        const int row0 = u.pm * BM + wr * 64 + fr, col0 = u.pn * BM + wc * 32 + 8 * fq;
#pragma unroll
        for (int ai = 0; ai < 2; ++ai)
#pragma unroll
            for (int m = 0; m < 4; ++m) { bf16_t* rowp = O + (size_t)(row0 + ai * HALF + m * 16) * ldc + col0;
#pragma unroll
                for (int bj = 0; bj < 2; ++bj) { const f32x4 v0 = acc[ai][bj][m][0], v1 = acc[ai][bj][m][1];
                    u32x4 w; w.x = cvt_pk_bf16(v0[0], v0[1]); w.y = cvt_pk_bf16(v0[2], v0[3]); w.z = cvt_pk_bf16(v1[0], v1[1]); w.w = cvt_pk_bf16(v1[2], v1[3]);
                    *(u32x4*)(rowp + bj * HALF) = w; } }
    }
};
struct EpiResF32 {
    static constexpr bool PERM = false, AFTER_DRAIN = false;
    const float* base; float* out; int ldc; int pad;
    __device__ __forceinline__ void operator()(const f32x4 (&acc)[2][2][4][2], const Unit& u, int wr, int wc, int fr, int fq) const {
        const int col0 = u.pn * BM + wc * 32 + 4 * fq;
#pragma unroll
        for (int ai = 0; ai < 2; ++ai)
#pragma unroll
            for (int m = 0; m < 4; ++m) { const size_t off = (size_t)(u.pm * BM + ai * HALF + wr * 64 + m * 16 + fr) * ldc + col0;
#pragma unroll
                for (int bj = 0; bj < 2; ++bj)
#pragma unroll
                    for (int n = 0; n < 2; ++n) { const f32x4 b = *(const f32x4*)(base + off + bj * HALF + n * 16); *(f32x4*)(out + off + bj * HALF + n * 16) = b + acc[ai][bj][m][n]; } }
    }
};
struct EpiResNorm {
    static constexpr bool PERM = false, AFTER_DRAIN = false;
    const float* base; const bf16_t* baseb; bf16_t* xb; float* ssq; int ldc; int pad;
    __device__ __forceinline__ void operator()(const f32x4 (&acc)[2][2][4][2], const Unit& u, int wr, int wc, int fr, int fq) const {
        typedef unsigned u32x2v __attribute__((ext_vector_type(2)));
        const int col0 = u.pn * BM + wc * 32 + 4 * fq; const bool fb = base != nullptr;
#pragma unroll
        for (int ai = 0; ai < 2; ++ai)
#pragma unroll
            for (int m = 0; m < 4; ++m) { const int row = u.pm * BM + ai * HALF + wr * 64 + m * 16 + fr; const size_t off = (size_t)row * ldc + col0; float sq = 0.f;
#pragma unroll
                for (int bj = 0; bj < 2; ++bj)
#pragma unroll
                    for (int n = 0; n < 2; ++n) { f32x4 b;
                        if (fb) b = *(const f32x4*)(base + off + bj * HALF + n * 16);
                        else { const u32x2v w = *(const u32x2v*)(baseb + off + bj * HALF + n * 16); b = (f32x4){__builtin_bit_cast(float, w.x << 16), __builtin_bit_cast(float, w.x & 0xffff0000u), __builtin_bit_cast(float, w.y << 16), __builtin_bit_cast(float, w.y & 0xffff0000u)}; }
                        const f32x4 v = b + acc[ai][bj][m][n];
                        sq += (v[0] * v[0] + v[1] * v[1]) + (v[2] * v[2] + v[3] * v[3]);
                        u32x2v w; w.x = cvt_pk_bf16(v[0], v[1]); w.y = cvt_pk_bf16(v[2], v[3]); *(u32x2v*)(xb + off + bj * HALF + n * 16) = w; }
                sq += __shfl_xor(sq, 16); sq += __shfl_xor(sq, 32);
                if (fq == 0) (void)__builtin_amdgcn_global_atomic_fadd_f32((__attribute__((address_space(1))) float*)(ssq + row), sq); }
    }
};
struct EpiResB16 {
    static constexpr bool PERM = false, AFTER_DRAIN = false;
    const bf16_t* baseb; float* out; int ldc; int pad;
    __device__ __forceinline__ void operator()(const f32x4 (&acc)[2][2][4][2], const Unit& u, int wr, int wc, int fr, int fq) const {
        typedef unsigned u32x2v __attribute__((ext_vector_type(2)));
        const int col0 = u.pn * BM + wc * 32 + 4 * fq;
#pragma unroll
        for (int ai = 0; ai < 2; ++ai)
#pragma unroll
            for (int m = 0; m < 4; ++m) { const size_t off = (size_t)(u.pm * BM + ai * HALF + wr * 64 + m * 16 + fr) * ldc + col0;
#pragma unroll
                for (int bj = 0; bj < 2; ++bj)
#pragma unroll
                    for (int n = 0; n < 2; ++n) { const u32x2v w = *(const u32x2v*)(baseb + off + bj * HALF + n * 16);
                        const f32x4 b = (f32x4){__builtin_bit_cast(float, w.x << 16), __builtin_bit_cast(float, w.x & 0xffff0000u), __builtin_bit_cast(float, w.y << 16), __builtin_bit_cast(float, w.y & 0xffff0000u)};
                        *(f32x4*)(out + off + bj * HALF + n * 16) = b + acc[ai][bj][m][n]; } }
    }
};
struct EpiStoreRS {
    static constexpr bool PERM = true, AFTER_DRAIN = false;
    bf16_t* O; const float* ssq; int ldc; float inv_ncols; float eps; int pad;
    __device__ __forceinline__ void operator()(const f32x4 (&acc)[2][2][4][2], const Unit& u, int wr, int wc, int fr, int fq) const {
        const int row0 = u.pm * BM + wr * 64 + fr, col0 = u.pn * BM + wc * 32 + 8 * fq;
#pragma unroll
        for (int ai = 0; ai < 2; ++ai)
#pragma unroll
            for (int m = 0; m < 4; ++m) { const int row = row0 + ai * HALF + m * 16; bf16_t* rowp = O + (size_t)row * ldc + col0; const float rs = __builtin_amdgcn_rsqf(ssq[row] * inv_ncols + eps);
#pragma unroll
                for (int bj = 0; bj < 2; ++bj) { const f32x4 v0 = acc[ai][bj][m][0] * rs, v1 = acc[ai][bj][m][1] * rs;
                    u32x4 w; w.x = cvt_pk_bf16(v0[0], v0[1]); w.y = cvt_pk_bf16(v0[2], v0[3]); w.z = cvt_pk_bf16(v1[0], v1[1]); w.w = cvt_pk_bf16(v1[2], v1[3]);
                    *(u32x4*)(rowp + bj * HALF) = w; } }
    }
};
struct EpiSwiGLURS {
    static constexpr bool PERM = true, AFTER_DRAIN = false;
    bf16_t* H; const float* ssq; int ldh; float inv_ncols; float eps; int pad;
    __device__ __forceinline__ void operator()(const f32x4 (&acc)[2][2][4][2], const Unit& u, int wr, int wc, int fr, int fq) const {
        typedef unsigned u32x2v __attribute__((ext_vector_type(2)));
        const int row0 = u.pm * BM + wr * 64 + fr, col0 = (u.pn * BM + wc * 32 + 8 * fq) >> 1;
#pragma unroll
        for (int ai = 0; ai < 2; ++ai)
#pragma unroll
            for (int m = 0; m < 4; ++m) { const int row = row0 + ai * HALF + m * 16; bf16_t* rowp = H + (size_t)row * ldh + col0; const float rs = __builtin_amdgcn_rsqf(ssq[row] * inv_ncols + eps);
#pragma unroll
                for (int bj = 0; bj < 2; ++bj) { const f32x4 g = acc[ai][bj][m][0] * rs, up = acc[ai][bj][m][1] * rs; float o[4];
#pragma unroll
                    for (int e = 0; e < 4; ++e) { const float ex = __builtin_amdgcn_exp2f(g[e] * -1.4426950408889634f); o[e] = g[e] * __builtin_amdgcn_rcpf(1.0f + ex) * up[e]; }
                    u32x2v w; w.x = cvt_pk_bf16(o[0], o[1]); w.y = cvt_pk_bf16(o[2], o[3]);
                    *(u32x2v*)(rowp + bj * (HALF / 2)) = w; } }
    }
};
struct EpiSwiGLU {
    static constexpr bool PERM = true, AFTER_DRAIN = false;
    bf16_t* H; int ldh; int pad;
    __device__ __forceinline__ void operator()(const f32x4 (&acc)[2][2][4][2], const Unit& u, int wr, int wc, int fr, int fq) const {
        typedef unsigned u32x2v __attribute__((ext_vector_type(2)));
        const int row0 = u.pm * BM + wr * 64 + fr, col0 = (u.pn * BM + wc * 32 + 8 * fq) >> 1;
#pragma unroll
        for (int ai = 0; ai < 2; ++ai)
#pragma unroll
            for (int m = 0; m < 4; ++m) { bf16_t* rowp = H + (size_t)(row0 + ai * HALF + m * 16) * ldh + col0;
#pragma unroll
                for (int bj = 0; bj < 2; ++bj) { const f32x4 g = acc[ai][bj][m][0], up = acc[ai][bj][m][1]; float o[4];
#pragma unroll
                    for (int e = 0; e < 4; ++e) { const float ex = __builtin_amdgcn_exp2f(g[e] * -1.4426950408889634f); o[e] = g[e] * __builtin_amdgcn_rcpf(1.0f + ex) * up[e]; }
                    u32x2v w; w.x = cvt_pk_bf16(o[0], o[1]); w.y = cvt_pk_bf16(o[2], o[3]);
                    *(u32x2v*)(rowp + bj * (HALF / 2)) = w; } }
    }
};
template <class Epi, class Sched, bool ALIGN_EPI = false, bool SP2 = false>
__device__ __forceinline__ void gemm_phase(PG8_LAS unsigned char* lds, const Gemm g, const Sched& S, const Epi& E) {
    const int tid = tid_opaque(), wid = __builtin_amdgcn_readfirstlane(tid >> 6), lane = tid & 63, wr = wid >> 2, wc = wid & 3, fr = lane & 15, fq = lane >> 4;
    const int K = g.K, nt = K / BK;
    unsigned voffA[2], voffB[2];
#pragma unroll
    for (int i = 0; i < 2; ++i) { int R, C; stage_rc(tid * 16 + i * 8192, R, C); const int Rb = Epi::PERM ? ((R & ~31) + perm32(R & 31)) : R;
        voffA[i] = (unsigned)(R * g.lda + C) * 2u; voffB[i] = (unsigned)(Rb * g.ldb + C) * 2u; }
    const size_t kstep = (size_t)(BK * 2);
    const size_t hstepA = (size_t)HALF * g.lda * 2, hstepB = (size_t)HALF * g.ldb * 2;
    const size_t tstepA = 2 * hstepA, tstepB = 2 * hstepB;
    const unsigned ldsw = (unsigned)wid * 1024u;
    const int aoff = lds_byte(wr * 64 + fr, fq * 8), boff = lds_byte(wc * 32 + fr, fq * 8);
#define PG8_SA(b, h) (((b) * 2 + (h)) * HTB)
#define PG8_SB(b, h) ((4 + (b) * 2 + (h)) * HTB)
#define PG8_STAGE(bufoff, gbase, voff) do { _Pragma("unroll") for (int _i = 0; _i < 2; ++_i) \
        __builtin_amdgcn_global_load_lds((const unsigned*)((const char*)(gbase) + (voff)[_i]), (PG8_LAS unsigned*)(lds + (bufoff) + ldsw + _i * 8192), 16, 0, 0); } while (0)
#define PG8_LDA(dst, b, h) do { _Pragma("unroll") for (int m = 0; m < 4; ++m) _Pragma("unroll") for (int k = 0; k < 2; ++k) dst[m][k] = *(const PG8_LAS bf16x8*)(lds + PG8_SA(b, h) + aoff + m * 2048 + k * 1024); } while (0)
#define PG8_LDB(dst, b, h) do { _Pragma("unroll") for (int n = 0; n < 2; ++n) _Pragma("unroll") for (int k = 0; k < 2; ++k) dst[n][k] = *(const PG8_LAS bf16x8*)(lds + PG8_SB(b, h) + boff + n * 2048 + k * 1024); } while (0)
#define PG8_MMA(ai, bj, At, Bt) do { __builtin_amdgcn_s_setprio(1); _Pragma("unroll") for (int m = 0; m < 4; ++m) _Pragma("unroll") for (int n = 0; n < 2; ++n) _Pragma("unroll") for (int k = 0; k < 2; ++k) \
        acc[ai][bj][m][n] = __builtin_amdgcn_mfma_f32_16x16x32_bf16(Bt[n][k], At[m][k], acc[ai][bj][m][n], 0, 0, 0); __builtin_amdgcn_s_setprio(0); } while (0)
#define PG8_WAIT_V(n) asm volatile("s_waitcnt vmcnt(" #n ")" ::: "memory")
#define PG8_WAIT_L(n) asm volatile("s_waitcnt lgkmcnt(" #n ")" ::: "memory")
#define PG8_BAR __builtin_amdgcn_s_barrier()
#define PG8_SCHED __builtin_amdgcn_sched_barrier(0)
    Unit cur, nxt; int ui = 0;
    if (!S.next(0, cur)) return;
    f32x4 acc[2][2][4][2];
#pragma unroll
    for (int a = 0; a < 2; ++a)
#pragma unroll
        for (int b = 0; b < 2; ++b)
#pragma unroll
            for (int m = 0; m < 4; ++m)
#pragma unroll
                for (int n = 0; n < 2; ++n) acc[a][b][m][n] = (f32x4){0.f, 0.f, 0.f, 0.f};
    bf16x8 At[4][2], B0[2][2], B1[2][2];
    const char* cA = (const char*)g.A + (size_t)cur.pm * tstepA; const char* cB = (const char*)g.Bt + (size_t)cur.pn * tstepB;
    S.a_ready(cur);
    if constexpr (SP2) {
        PG8_STAGE(PG8_SB(0, 0), cB, voffB); PG8_STAGE(PG8_SB(0, 1), cB + hstepB, voffB); PG8_STAGE(PG8_SA(0, 0), cA, voffA); PG8_STAGE(PG8_SA(0, 1), cA + hstepA, voffA);
        if (wr == 1) PG8_BAR;
        PG8_WAIT_V(2); PG8_BAR;
        PG8_STAGE(PG8_SB(1, 0), cB + kstep, voffB); PG8_STAGE(PG8_SA(1, 0), cA + kstep, voffA); PG8_STAGE(PG8_SB(1, 1), cB + hstepB + kstep, voffB);
        PG8_WAIT_V(6); PG8_BAR;
    } else {
        PG8_STAGE(PG8_SB(0, 0), cB, voffB); PG8_STAGE(PG8_SA(0, 0), cA, voffA); PG8_STAGE(PG8_SB(0, 1), cB + hstepB, voffB); PG8_STAGE(PG8_SA(0, 1), cA + hstepA, voffA);
        if (wr == 1) PG8_BAR;
        PG8_WAIT_V(4); PG8_BAR;
        PG8_STAGE(PG8_SB(1, 0), cB + kstep, voffB); PG8_STAGE(PG8_SA(1, 0), cA + kstep, voffA); PG8_STAGE(PG8_SB(1, 1), cB + hstepB + kstep, voffB);
        PG8_WAIT_V(6); PG8_BAR;
    }
    for (;;) {
        const bool has_next = S.next(ui + 1, nxt);
        const char* nA = has_next ? (const char*)g.A + (size_t)nxt.pm * tstepA : cA; const char* nB = has_next ? (const char*)g.Bt + (size_t)nxt.pn * tstepB : cB;
        for (int t = 0; t < nt; t += 2) {
            const bool last = (t == nt - 2);
            const char* a1 = cA + (size_t)(t + 1) * kstep;
            const char* a2 = last ? nA : cA + (size_t)(t + 2) * kstep; const char* b2 = last ? nB : cB + (size_t)(t + 2) * kstep;
            const char* a3 = a2 + kstep; const char* b3 = b2 + kstep;
            if (last && has_next) S.a_ready(nxt);
            if constexpr (SP2) {
            PG8_LDB(B0, 0, 0); PG8_LDB(B1, 0, 1); PG8_SCHED; PG8_LDA(At, 0, 0); PG8_STAGE(PG8_SA(1, 1), a1 + hstepA, voffA);
            PG8_WAIT_V(8); PG8_WAIT_L(0); PG8_BAR; PG8_MMA(0, 0, At, B0); PG8_MMA(0, 1, At, B1); PG8_BAR; PG8_SCHED;
            PG8_LDA(At, 0, 1); PG8_STAGE(PG8_SB(0, 0), b2, voffB); PG8_STAGE(PG8_SB(0, 1), b2 + hstepB, voffB); PG8_STAGE(PG8_SA(0, 0), a2, voffA);
            PG8_WAIT_V(8); PG8_WAIT_L(0); PG8_BAR; PG8_MMA(1, 0, At, B0); PG8_MMA(1, 1, At, B1); PG8_BAR; PG8_SCHED;
            PG8_LDB(B0, 1, 0); PG8_LDB(B1, 1, 1); PG8_SCHED; PG8_LDA(At, 1, 0); PG8_STAGE(PG8_SA(0, 1), a2 + hstepA, voffA);
            PG8_WAIT_V(8); PG8_WAIT_L(0); PG8_BAR; PG8_MMA(0, 0, At, B0); PG8_MMA(0, 1, At, B1); PG8_BAR; PG8_SCHED;
            PG8_LDA(At, 1, 1); PG8_STAGE(PG8_SB(1, 0), b3, voffB); PG8_STAGE(PG8_SB(1, 1), b3 + hstepB, voffB); PG8_STAGE(PG8_SA(1, 0), a3, voffA);
            PG8_WAIT_V(8); PG8_WAIT_L(0); PG8_BAR; PG8_MMA(1, 0, At, B0); PG8_MMA(1, 1, At, B1); PG8_BAR; PG8_SCHED;
            } else {
            PG8_LDB(B0, 0, 0); PG8_SCHED; PG8_LDA(At, 0, 0); PG8_STAGE(PG8_SA(1, 1), a1 + hstepA, voffA);
            PG8_WAIT_L(8); PG8_BAR; PG8_WAIT_L(0); PG8_MMA(0, 0, At, B0); PG8_BAR; PG8_SCHED;
            PG8_LDB(B1, 0, 1); PG8_STAGE(PG8_SB(0, 0), b2, voffB);
            PG8_BAR; PG8_WAIT_L(0); PG8_MMA(0, 1, At, B1); PG8_BAR;
            PG8_LDA(At, 0, 1); PG8_STAGE(PG8_SA(0, 0), a2, voffA);
            PG8_BAR; PG8_WAIT_L(0); PG8_MMA(1, 0, At, B0); PG8_BAR; PG8_SCHED;
            PG8_STAGE(PG8_SB(0, 1), b2 + hstepB, voffB);
            PG8_WAIT_V(6); PG8_BAR; PG8_MMA(1, 1, At, B1); PG8_BAR;
            PG8_LDB(B0, 1, 0); PG8_SCHED; PG8_LDA(At, 1, 0); PG8_STAGE(PG8_SA(0, 1), a2 + hstepA, voffA);
            PG8_WAIT_L(8); PG8_BAR; PG8_WAIT_L(0); PG8_MMA(0, 0, At, B0); PG8_BAR; PG8_SCHED;
            PG8_LDB(B1, 1, 1); PG8_STAGE(PG8_SB(1, 0), b3, voffB);
            PG8_BAR; PG8_WAIT_L(0); PG8_MMA(0, 1, At, B1); PG8_BAR;
            PG8_LDA(At, 1, 1); PG8_STAGE(PG8_SA(1, 0), a3, voffA);
            PG8_BAR; PG8_WAIT_L(0); PG8_MMA(1, 0, At, B0); PG8_BAR; PG8_SCHED;
            PG8_STAGE(PG8_SB(1, 1), b3 + hstepB, voffB);
            PG8_WAIT_V(6); PG8_BAR; PG8_MMA(1, 1, At, B1); PG8_BAR;
            }
        }
        if constexpr (ALIGN_EPI) { if (wr == 0) PG8_BAR; }
        if constexpr (!Epi::AFTER_DRAIN) { E(acc, cur, wr, wc, fr, fq); S.done(cur); }
        if (!has_next) break;
#pragma unroll
        for (int a = 0; a < 2; ++a)
#pragma unroll
            for (int b = 0; b < 2; ++b)
#pragma unroll
                for (int m = 0; m < 4; ++m)
#pragma unroll
                    for (int n = 0; n < 2; ++n) acc[a][b][m][n] = (f32x4){0.f, 0.f, 0.f, 0.f};
        cur = nxt; cA = nA; cB = nB; ++ui;
        if constexpr (ALIGN_EPI) { if (wr == 1) PG8_BAR; }
    }
    PG8_WAIT_V(0);
    if constexpr (!ALIGN_EPI) { if (wr == 0) PG8_BAR; }
    PG8_BAR;
    if constexpr (Epi::AFTER_DRAIN) { E.fused(acc, cur, wr, wc, fr, fq, lds, wid, lane); S.done(cur); }
#undef PG8_SA
#undef PG8_SB
#undef PG8_STAGE
#undef PG8_LDA
#undef PG8_LDB
#undef PG8_MMA
#undef PG8_WAIT_V
#undef PG8_WAIT_L
#undef PG8_BAR
#undef PG8_SCHED
}
}

constexpr int BATCH = 4, SEQ = 8192, DM = 1024, M = BATCH * SEQ, NMEM = 256;
constexpr int PP = 1792;
constexpr int C_CQ = 0, C_CKV = 256, C_KPE = 384, C_QD = 416, C_KD = 928, C_VD = 1056, C_QI = 1184, C_KI = 1696, C_WI = 1760, IN_COLS = 1768;
constexpr int DFF = 2816;
constexpr float EPS = 1e-6f, LOG2E = 1.4426950408889634f;
constexpr float SC_MLA = 0.10206207261596577f * LOG2E;
constexpr float SC_DSA = 0.125f * LOG2E;
constexpr float SC_MEM = 0.08838834764831845f * LOG2E;
constexpr float SC_IDX = 0.125f;
constexpr int ROPE_W = 48;

typedef unsigned short bf16_t;
typedef unsigned u32x4 __attribute__((ext_vector_type(4)));
typedef unsigned u32x2 __attribute__((ext_vector_type(2)));
typedef float f32x4 __attribute__((ext_vector_type(4)));
#define LAS __attribute__((address_space(3)))

constexpr size_t MiB = 1u << 20;
constexpr size_t WS_CTL = 0;
constexpr size_t WS_WIN = 1 * MiB;
constexpr size_t WS_WUQ = WS_WIN + (size_t)PP * 1024 * 2;
constexpr size_t WS_WUKV = WS_WUQ + 768 * 256 * 2;
constexpr size_t WS_WOUT = WS_WUKV + 1024 * 128 * 2;
constexpr size_t WS_WMQ = WS_WOUT + 1024 * 1024 * 2;
constexpr size_t WS_WMKV = WS_WMQ + 512 * 1024 * 2;
constexpr size_t WS_WMO = WS_WMKV + 1024 * 1024 * 2;
constexpr size_t WS_WGU = WS_WMO + 1024 * 512 * 2;
constexpr size_t WS_WDN = WS_WGU + (size_t)5632 * 1024 * 2;
constexpr size_t WS_WEND = WS_WDN + (size_t)1024 * 2816 * 2;
static_assert(WS_WEND <= 29 * MiB, "weights");
constexpr size_t WS_SSQ1 = 28 * MiB, WS_SSQ2 = WS_SSQ1 + (size_t)M * 4, WS_SSQ_CQ = WS_SSQ2 + (size_t)M * 4, WS_SSQ_CKV = WS_SSQ_CQ + (size_t)M * 4, WS_SS_PE = WS_SSQ_CKV + (size_t)M * 4;
static_assert(WS_WEND <= WS_SSQ1 && WS_SS_PE + (size_t)M * 4 <= 29 * MiB, "ssq");
constexpr size_t WS_ROPE = 29 * MiB;
constexpr size_t WS_MEMN = 35 * MiB;
constexpr size_t WS_KVC = 37 * MiB;
constexpr size_t WS_WI = 39 * MiB;
constexpr size_t WS_KI = 40 * MiB;
constexpr size_t WS_KVD = 44 * MiB;
constexpr size_t WS_SEL = 60 * MiB;
constexpr size_t WS_XN = 76 * MiB;
constexpr size_t WS_MIX = 140 * MiB;
constexpr size_t WS_QC = 428 * MiB;
constexpr size_t WS_PROJ = 204 * MiB;
constexpr size_t WS_QM = 316 * MiB;
constexpr size_t WS_KVM = 364 * MiB;
constexpr size_t WS_KM = 428 * MiB;
constexpr size_t WS_H = 204 * MiB;
constexpr size_t WS_END = 476 * MiB;
static_assert(WS_H + (size_t)M * DFF * 2 <= WS_KM, "H overlay");

__device__ __forceinline__ unsigned f2bf(float f) { unsigned u = __builtin_bit_cast(unsigned, f); return (u + 0x7fffu + ((u >> 16) & 1u)) >> 16; }
__device__ __forceinline__ unsigned pk2(float lo, float hi) { return f2bf(lo) | (f2bf(hi) << 16); }
__device__ __forceinline__ float bf2f(unsigned short h) { return __builtin_bit_cast(float, (unsigned)h << 16); }
__device__ __forceinline__ float bflo(unsigned w) { return __builtin_bit_cast(float, w << 16); }
__device__ __forceinline__ float bfhi(unsigned w) { return __builtin_bit_cast(float, w & 0xffff0000u); }
__device__ __forceinline__ float wave_sum(float v) {
#pragma unroll
    for (int o = 1; o < 64; o <<= 1) v += __shfl_xor(v, o);
    return v;
}
__device__ __forceinline__ float wave_max(float v) {
#pragma unroll
    for (int o = 1; o < 64; o <<= 1) v = fmaxf(v, __shfl_xor(v, o));
    return v;
}


#define XB_TMO      128
#define XB_XCNT(j)  (256  + 64 * (j))
#define XB_XSUB(j)  (1280 + 64 * (j))
#define XB_XGEN(j)  (2304 + 64 * (j))
#define XB_TOP      3328
#define XB_TOPGEN   3392
#define XB_GSUB(j)  (3456 + 64 * (j))
#define XB_GGEN(j)  (3968 + 64 * (j))
#define XB_TAB      4480
#define XCD_BAR_WORDS 5504
#define XB_SPIN_CAP (1u << 24)

__device__ __forceinline__ unsigned xb_ld(unsigned* p)              { return __hip_atomic_load(p, __ATOMIC_RELAXED, __HIP_MEMORY_SCOPE_AGENT); }
__device__ __forceinline__ unsigned xb_add(unsigned* p, unsigned v) { return __hip_atomic_fetch_add(p, v, __ATOMIC_RELAXED, __HIP_MEMORY_SCOPE_AGENT); }
__device__ __forceinline__ unsigned xb_xcc_id() { return (unsigned)__builtin_amdgcn_s_getreg((3 << 11) | 20) & 0xFu; }
#define XB_SPIN(cond, bar) do { unsigned _sp = 0; while (cond) { __builtin_amdgcn_s_sleep(1); \
    if ((++_sp & 255u) == 0u) { if (xb_ld(&(bar)[XB_TMO])) break; if (_sp > XB_SPIN_CAP) { atomicAdd(&(bar)[XB_TMO], 1u); break; } } } } while (0)

struct XcdBarrier {
    unsigned* bar; unsigned x;
    volatile LAS unsigned* st;
};

__device__ __forceinline__ XcdBarrier xcd_barrier_post(unsigned* bar, volatile LAS unsigned* st) {
    XcdBarrier b; b.bar = bar; b.x = xb_xcc_id(); b.st = st;
    if (threadIdx.x == 0) {
        __hip_atomic_store(&bar[XB_TAB + blockIdx.x], b.x + 1u, __ATOMIC_RELAXED, __HIP_MEMORY_SCOPE_AGENT);
        asm volatile("s_waitcnt vmcnt(0)" ::: "memory");
        (void)xb_add(&bar[XB_XCNT(b.x)], 1u);
    }
    return b;
}
__device__ __forceinline__ void xcd_barrier_complete(unsigned* bar, unsigned x, unsigned& nloc, unsigned& nx) {
    const unsigned G = gridDim.x * gridDim.y * gridDim.z;
    unsigned sum, cnt, mine, sp = 0u;
    for (;;) {
        sum = 0u; cnt = 0u; mine = 0u;
#pragma unroll
        for (unsigned j = 0; j < 16; ++j) { const unsigned c = xb_ld(&bar[XB_XCNT(j)]); sum += c; cnt += (c > 0u) ? 1u : 0u; mine = (j == x) ? c : mine; }
        if (sum == G) break;
        __builtin_amdgcn_s_sleep(1);
        if ((++sp & 255u) == 0u) { if (xb_ld(&bar[XB_TMO])) break; if (sp > XB_SPIN_CAP) { atomicAdd(&bar[XB_TMO], 1u); break; } }
    }
    nloc = mine > 0u ? mine : 1u; nx = cnt > 0u ? cnt : 1u;
}

__device__ __forceinline__ void xcd_barrier(const XcdBarrier& b) {
    asm volatile("s_waitcnt vmcnt(0)" ::: "memory");
    __syncthreads();
    if (threadIdx.x == 0) {
        unsigned* bar = b.bar;
        __builtin_amdgcn_s_waitcnt(0);
        unsigned nloc = b.st[0], nx = b.st[1];
        if (nloc == 0u) { xcd_barrier_complete(bar, b.x, nloc, nx); b.st[0] = nloc; b.st[1] = nx;
            unsigned same = 1u; const unsigned G_ = gridDim.x;
            for (unsigned j = blockIdx.x & 7u; j < G_; j += 8u) same &= (xb_ld(&bar[XB_TAB + j]) == b.x + 1u) ? 1u : 0u;
            b.st[2] = 1u + same; }
        const unsigned old = xb_add(&bar[XB_XSUB(b.x)], 1u);
        const unsigned gen = old / nloc;
        if (old + 1u == (gen + 1u) * nloc) {
            __builtin_amdgcn_fence(__ATOMIC_RELEASE, "agent");
            asm volatile("s_waitcnt vmcnt(0)" ::: "memory");
            const unsigned og = xb_add(&bar[XB_TOP], 1u);
            const unsigned tg = og / nx;
            if (og + 1u == (tg + 1u) * nx) xb_add(&bar[XB_TOPGEN], 1u);
            else XB_SPIN(xb_ld(&bar[XB_TOPGEN]) == tg, bar);
            __builtin_amdgcn_fence(__ATOMIC_ACQUIRE, "agent");
            xb_add(&bar[XB_XGEN(b.x)], 1u);
            asm volatile("s_waitcnt vmcnt(0)" ::: "memory");
        } else {
            XB_SPIN(xb_ld(&bar[XB_XGEN(b.x)]) == gen, bar);
            __builtin_amdgcn_fence(__ATOMIC_ACQUIRE, "agent");
            asm volatile("s_waitcnt vmcnt(0)" ::: "memory");
        }
    }
    __syncthreads();
}
__device__ __forceinline__ void grp_barrier(const XcdBarrier& b) {
    asm volatile("s_waitcnt vmcnt(0)" ::: "memory");
    __syncthreads();
    if (threadIdx.x == 0) {
        unsigned* bar = b.bar;
        __builtin_amdgcn_s_waitcnt(0);
        const unsigned g = blockIdx.x & 7u, n = gridDim.x >> 3;
        if (b.st[2] != 2u) { __builtin_amdgcn_fence(__ATOMIC_RELEASE, "agent"); asm volatile("s_waitcnt vmcnt(0)" ::: "memory"); }
        const unsigned old = xb_add(&bar[XB_GSUB(g)], 1u);
        const unsigned gen = old / n;
        if (old + 1u == (gen + 1u) * n) xb_add(&bar[XB_GGEN(g)], 1u);
        else XB_SPIN(xb_ld(&bar[XB_GGEN(g)]) == gen, bar);
        __builtin_amdgcn_fence(__ATOMIC_ACQUIRE, "agent");
        asm volatile("s_waitcnt vmcnt(0)" ::: "memory");
    }
    __syncthreads();
}


constexpr int NWAVES = 8, NTHREADS = 512;
constexpr int RING_BYTES = 131072;
constexpr int MISC_OFF = RING_BYTES + 320;
constexpr int LDS_BYTES = 147456;
constexpr int CW_BAR = 4096;
constexpr size_t CTL_ZERO_BYTES = 64 * 1024;

struct Params { const float* in[27]; float* out; unsigned char* ws; };
typedef const unsigned long long volatile __attribute__((address_space(4))) * karg_ptr_t;
#define AS_GLOBAL(T, bits) ((T)(__attribute__((address_space(1))) void*)(bits))
__device__ __forceinline__ const void* karg(int i) { return AS_GLOBAL(const void*, ((karg_ptr_t)__builtin_amdgcn_kernarg_segment_ptr())[i]); }
#define P_IN(k) ((const float*)karg(k))
#define P_OUT ((float*)karg(27))
#define P_WS ((unsigned char*)karg(28))

__device__ __forceinline__ int proj_pi_inv(int d) { return d < 8 ? 8 * (d >> 1) + (d & 1) : d < 16 ? 8 * ((d - 8) >> 1) + 2 + ((d - 8) & 1) : d < 32 ? 8 * ((d - 16) >> 2) + 4 + ((d - 16) & 3) : d; }
__device__ __forceinline__ int proj_dst_row(int c) {
    int T, wc, j;
    if (c < C_CKV) { T = 0; wc = c >> 6; j = c & 63; }
    else if (c < C_KPE) { T = 1; wc = (c - C_CKV) >> 6; j = (c - C_CKV) & 63; }
    else if (c < C_QD) { T = 1; wc = 2; j = c - C_KPE; }
    else if (c < C_KD) { const int h = (c - C_QD) >> 6; T = 2 + (h >> 2); wc = h & 3; j = proj_pi_inv((c - C_QD) & 63); }
    else if (c < C_VD) { T = 6; wc = (c - C_KD) >> 6; j = proj_pi_inv((c - C_KD) & 63); }
    else if (c < C_QI) { T = 6; wc = 2 + ((c - C_VD) >> 6); j = (c - C_VD) & 63; }
    else if (c < C_KI) { const int h = (c - C_QI) >> 6; T = 4 + (h >> 2); wc = h & 3; j = proj_pi_inv((c - C_QI) & 63); }
    else if (c < C_WI) { T = 1; wc = 3; j = proj_pi_inv(c - C_KI); }
    else { T = 1; wc = 2; j = 32 + (c - C_WI); }
    return 256 * T + (j < 32 ? 32 * wc + j : 128 + 32 * wc + (j - 32));
}
__device__ __forceinline__ int kvm_dst_row(int c) { const int h = c >> 7, isv = (c >> 6) & 1, d = c & 63, wc = 2 * (h & 1) + isv; return 256 * (h >> 1) + (d < 32 ? 32 * wc + d : 128 + 32 * wc + (d - 32)); }
__device__ __forceinline__ int wt_dst_row(int c, int mode, int row_off) { return mode == 0 ? row_off + c : (mode == 1 ? ((c >> 2) * 8 + (c & 3) + row_off) : (mode == 2 ? proj_dst_row(c) : kvm_dst_row(c))); }
__device__ __forceinline__ void transpose_item(const float* W, int K, int Nsrc, bf16_t* WT, int mode, int row_off, const float* gk, LAS float* scr, int kb, int nb, int lane) {
    const int k0 = 64 * kb, n0 = 32 * nb;
    const int c = n0 + (lane & 31); const bool inb = c < Nsrc;
    const float* wp = W + (size_t)(k0 + (lane >> 5)) * Nsrc + (inb ? c : 0);
    float v[32];
#pragma unroll
    for (int i = 0; i < 32; ++i) v[i] = wp[(size_t)(2 * i) * Nsrc];
    if (gk) {
#pragma unroll
        for (int i = 0; i < 32; ++i) v[i] *= gk[k0 + 2 * i + (lane >> 5)];
    }
#pragma unroll
    for (int i = 0; i < 32; ++i) scr[(2 * i + (lane >> 5)) * 33 + (lane & 31)] = inb ? v[i] : 0.f;
    asm volatile("s_waitcnt lgkmcnt(0)" ::: "memory");
    const int ch = lane & 7;
#pragma unroll
    for (int j = 0; j < 4; ++j) { const int n = (lane >> 3) + 8 * j; const LAS float* s = scr + (8 * ch) * 33 + n;
        u32x4 o; o.x = pk2(s[0 * 33], s[1 * 33]); o.y = pk2(s[2 * 33], s[3 * 33]); o.z = pk2(s[4 * 33], s[5 * 33]); o.w = pk2(s[6 * 33], s[7 * 33]);
        *(u32x4*)(WT + (size_t)wt_dst_row(n0 + n, mode, row_off) * K + k0 + 8 * ch) = o; }
    asm volatile("s_waitcnt lgkmcnt(0)" ::: "memory");
}
struct WtJob { const float* W; bf16_t* WT; const float* gk; int K, Nsrc, Ncover, mode, row_off; };
constexpr int N_WT_JOBS = 11;
__device__ __forceinline__ WtJob wt_job(int i) {
    unsigned char* ws = P_WS; WtJob j;
    switch (i) {
        case 0:  j = WtJob{P_IN(4),  (bf16_t*)(ws + WS_WIN),  nullptr,  1024, IN_COLS, PP,   2, 0};   break;
        case 1:  j = WtJob{P_IN(6),  (bf16_t*)(ws + WS_WUQ),  P_IN(5),  256,  768,     768,  0, 0};   break;
        case 2:  j = WtJob{P_IN(8),  (bf16_t*)(ws + WS_WUKV), P_IN(7),  128,  1024,    1024, 3, 0};   break;
        case 3:  j = WtJob{P_IN(14), (bf16_t*)(ws + WS_WOUT), nullptr,  1024, 1024,    1024, 0, 0};   break;
        case 4:  j = WtJob{P_IN(17), (bf16_t*)(ws + WS_WMQ),  P_IN(15), 1024, 512,     512,  0, 0};   break;
        case 5:  j = WtJob{P_IN(18), (bf16_t*)(ws + WS_WMKV), nullptr,  1024, 512,     512,  0, 0};   break;
        case 6:  j = WtJob{P_IN(19), (bf16_t*)(ws + WS_WMKV), nullptr,  1024, 512,     512,  0, 512}; break;
        case 7:  j = WtJob{P_IN(22), (bf16_t*)(ws + WS_WMO),  nullptr,  512,  1024,    1024, 0, 0};   break;
        case 8:  j = WtJob{P_IN(24), (bf16_t*)(ws + WS_WGU),  P_IN(23), 1024, DFF,     DFF,  1, 0};   break;
        case 9:  j = WtJob{P_IN(25), (bf16_t*)(ws + WS_WGU),  P_IN(23), 1024, DFF,     DFF,  1, 4};   break;
        default: j = WtJob{P_IN(26), (bf16_t*)(ws + WS_WDN),  nullptr,  DFF,  1024,    1024, 0, 0};   break;
    }
    return j;
}
__device__ __forceinline__ void ph_weights(LAS unsigned char* L, int gw, int NGW, int wave, int lane, bool early) {
    LAS float* scr = (LAS float*)(L + wave * 16384);
    int base = 0;
    for (int ji = 0; ji < N_WT_JOBS; ++ji) {
        if (((ji == 0) || (ji == 5) || (ji == 6)) != early) continue;
        const WtJob jb = wt_job(ji);
        const int nnb = jb.Ncover / 32, nitems = (jb.K / 64) * nnb;
        int first = (gw - base % NGW + NGW) % NGW;
        for (int it = first; it < nitems; it += NGW) transpose_item(jb.W, jb.K, jb.Nsrc, jb.WT, jb.mode, jb.row_off, jb.gk, scr, it / nnb, it % nnb, lane);
        base += nitems;
    }
}
__device__ __forceinline__ void rms_row_1024(const float* xrow, const float* g, bf16_t* orow, int lane) {
    const f32x4* xr = (const f32x4*)xrow + lane; const f32x4* gr = (const f32x4*)g + lane;
    f32x4 v[4]; float s = 0.f;
#pragma unroll
    for (int j = 0; j < 4; ++j) { v[j] = xr[64 * j]; s += (v[j].x * v[j].x + v[j].y * v[j].y) + (v[j].z * v[j].z + v[j].w * v[j].w); }
    const float rstd = 1.0f / sqrtf(wave_sum(s) * (1.f / 1024.f) + EPS);
    unsigned long long* o8 = (unsigned long long*)orow + lane;
#pragma unroll
    for (int j = 0; j < 4; ++j) { const f32x4 gg = gr[64 * j]; o8[64 * j] = (unsigned long long)pk2(v[j].x * rstd * gg.x, v[j].y * rstd * gg.y) | ((unsigned long long)pk2(v[j].z * rstd * gg.z, v[j].w * rstd * gg.w) << 32); }
}
__device__ __forceinline__ void ph_rmsnorm_rows(const float* X, const float* g, bf16_t* O, int R, int gw, int NGW, int lane) {
    const f32x4* gr = (const f32x4*)g + lane;
    for (int r0 = gw * 4; r0 < R; r0 += NGW * 4) {
        f32x4 v[4][4];
#pragma unroll
        for (int q = 0; q < 4; ++q) { const f32x4* xr = (const f32x4*)(X + (size_t)(r0 + q) * 1024) + lane;
#pragma unroll
            for (int j = 0; j < 4; ++j) v[q][j] = xr[64 * j]; }
#pragma unroll
        for (int q = 0; q < 4; ++q) { float s = 0.f;
#pragma unroll
            for (int j = 0; j < 4; ++j) s += (v[q][j].x * v[q][j].x + v[q][j].y * v[q][j].y) + (v[q][j].z * v[q][j].z + v[q][j].w * v[q][j].w);
            const float rstd = 1.0f / sqrtf(wave_sum(s) * (1.f / 1024.f) + EPS);
            unsigned long long* o8 = (unsigned long long*)(O + (size_t)(r0 + q) * 1024) + lane;
#pragma unroll
            for (int j = 0; j < 4; ++j) { const f32x4 gg = gr[64 * j]; o8[64 * j] = (unsigned long long)pk2(v[q][j].x * rstd * gg.x, v[q][j].y * rstd * gg.y) | ((unsigned long long)pk2(v[q][j].z * rstd * gg.z, v[q][j].w * rstd * gg.w) << 32); } }
    }
}
__device__ __forceinline__ void ph_rope(const int* pos, float* tab, int gtid, int NGT) {
    for (int i = gtid; i < M * 24; i += NGT) {
        const int tok = i / 24, j = i % 24;
        const float e = (j < 16) ? (float)j * (1.0f / 16.0f) : (float)(j - 16) * (1.0f / 8.0f);
        const float inv = exp2f(-e * 18.931568569324174f);
        const float ang = (float)pos[tok] * inv;
        const double rev = (double)ang * 0.15915494309189535; const float fr = (float)(rev - rint(rev));
        const float c = __builtin_amdgcn_cosf(fr), s = __builtin_amdgcn_sinf(fr);
        float* t = tab + (size_t)tok * ROPE_W;
        if (j < 16) { t[j] = c; t[16 + j] = s; } else { t[32 + (j - 16)] = c; t[40 + (j - 16)] = s; }
    }
}

struct Post1Args { bf16_t* proj; bf16_t* kvd; bf16_t* ki; float* wi; const float* rope; const float* g_dq; const float* g_dk; const float* g_ik; bf16_t* pout; };
__device__ __forceinline__ void unpack8(const u32x4 w, float (&v)[8]) { v[0] = bflo(w.x); v[1] = bfhi(w.x); v[2] = bflo(w.y); v[3] = bfhi(w.y); v[4] = bflo(w.z); v[5] = bfhi(w.z); v[6] = bflo(w.w); v[7] = bfhi(w.w); }
__device__ __forceinline__ u32x4 pack8(const float (&v)[8]) { u32x4 w; w.x = pk2(v[0], v[1]); w.y = pk2(v[2], v[3]); w.z = pk2(v[4], v[5]); w.w = pk2(v[6], v[7]); return w; }
__device__ __forceinline__ void ph_post1(const Post1Args& a, LAS unsigned char* L, int gw, int NGW, int wave, int lane) {
    (void)L; (void)wave;
    const int sub = lane & 7;
    const int offA = lane < 32 ? C_CQ + 8 * lane : (lane < 48 ? C_CKV + 8 * (lane - 32) : -1);
    const int offD = lane < 16 ? C_KD + 8 * lane : (lane < 24 ? C_KI + 8 * (lane - 16) : (lane >= 32 && lane < 48 ? C_VD + 8 * (lane - 32) : (lane == 48 ? C_WI : -1)));
    float gB[8], gD[8];
#pragma unroll
    for (int e = 0; e < 8; ++e) { gB[e] = a.g_dq[sub * 8 + e]; gD[e] = lane < 16 ? a.g_dk[sub * 8 + e] : (lane < 24 ? a.g_ik[sub * 8 + e] : 1.f); }
    u32x4 nA, nB, nC, nD; f32x4 nr[4];
#define P1_LOAD(tk) do { const bf16_t* pr_ = a.proj + (size_t)(tk) * PP; const f32x4* rt_ = (const f32x4*)(a.rope + (size_t)(tk) * ROPE_W + 32); \
        nA = (u32x4){0u, 0u, 0u, 0u}; nD = nA; if (offA >= 0) nA = *(const u32x4*)(pr_ + offA); nB = *(const u32x4*)(pr_ + C_QD + 8 * lane); nC = *(const u32x4*)(pr_ + C_QI + 8 * lane); \
        if (offD >= 0) nD = *(const u32x4*)(pr_ + offD); nr[0] = rt_[0]; nr[1] = rt_[1]; nr[2] = rt_[2]; nr[3] = rt_[3]; } while (0)
    if (gw < M) P1_LOAD(gw);
    for (int tok = gw; tok < M; tok += NGW) {
        const u32x4 cA = nA, cB = nB, cC = nC, cD = nD; const float cp[8] = {nr[0].x, nr[0].y, nr[0].z, nr[0].w, nr[1].x, nr[1].y, nr[1].z, nr[1].w}, sp[8] = {nr[2].x, nr[2].y, nr[2].z, nr[2].w, nr[3].x, nr[3].y, nr[3].z, nr[3].w};
        if (tok + NGW < M) P1_LOAD(tok + NGW);
        bf16_t* po = a.pout + (size_t)tok * PP;
        float v[8];
        { unpack8(cA, v); float s = 0.f;
#pragma unroll
          for (int e = 0; e < 8; ++e) s += v[e] * v[e];
          s += __shfl_xor(s, 1); s += __shfl_xor(s, 2); s += __shfl_xor(s, 4); s += __shfl_xor(s, 8);
          { const float t16 = __shfl_xor(s, 16); if (lane < 32) s += t16; }
          const float r = __builtin_amdgcn_rsqf(s * (lane < 32 ? 1.f / 256.f : 1.f / 128.f) + EPS);
#pragma unroll
          for (int e = 0; e < 8; ++e) v[e] *= r;
          if (offA >= 0) *(u32x4*)(po + offA) = pack8(v); }
#pragma unroll
        for (int pass = 0; pass < 2; ++pass) { unpack8(pass == 0 ? cB : cC, v);
            if (pass == 0) { float s = 0.f;
#pragma unroll
                for (int e = 0; e < 8; ++e) s += v[e] * v[e];
                s += __shfl_xor(s, 1); s += __shfl_xor(s, 2); s += __shfl_xor(s, 4);
                const float r = __builtin_amdgcn_rsqf(s * (1.f / 64.f) + EPS);
#pragma unroll
                for (int e = 0; e < 8; ++e) v[e] *= r * gB[e]; }
#pragma unroll
            for (int e = 0; e < 8; ++e) { const float o = __shfl_xor(v[e], 1); if (sub == 0) v[e] = v[e] * cp[e] - o * sp[e]; else if (sub == 1) v[e] = v[e] * cp[e] + o * sp[e]; }
            const float sc = pass == 0 ? SC_DSA : SC_IDX;
#pragma unroll
            for (int e = 0; e < 8; ++e) v[e] *= sc;
            *(u32x4*)(po + (pass == 0 ? C_QD : C_QI) + 8 * lane) = pack8(v); }
        { unpack8(cD, v); float s = 0.f;
#pragma unroll
          for (int e = 0; e < 8; ++e) s += v[e] * v[e];
          s += __shfl_xor(s, 1); s += __shfl_xor(s, 2); s += __shfl_xor(s, 4);
          const float r = lane < 24 ? __builtin_amdgcn_rsqf(s * (1.f / 64.f) + EPS) : 1.f;
          float u[8];
#pragma unroll
          for (int e = 0; e < 8; ++e) u[e] = v[e] * r * gD[e];
#pragma unroll
          for (int e = 0; e < 8; ++e) { const float o = __shfl_xor(u[e], 1); if (lane < 24) { if (sub == 0) u[e] = u[e] * cp[e] - o * sp[e]; else if (sub == 1) u[e] = u[e] * cp[e] + o * sp[e]; } }
          if (lane < 16) *(u32x4*)(a.kvd + (size_t)tok * 256 + 8 * lane) = pack8(u);
          else if (lane < 24) *(u32x4*)(a.ki + (size_t)tok * 64 + 8 * (lane - 16)) = pack8(u);
          else if (lane >= 32 && lane < 48) *(u32x4*)(a.kvd + (size_t)tok * 256 + 128 + 8 * (lane - 32)) = cD;
          else if (lane == 48) { float* wp = a.wi + (size_t)tok * 8; *(f32x4*)wp = (f32x4){v[0], v[1], v[2], v[3]} * 0.35355339059327373f; *(f32x4*)(wp + 4) = (f32x4){v[4], v[5], v[6], v[7]} * 0.35355339059327373f; } }
    }
#undef P1_LOAD
}
struct Post2Args { bf16_t* qm; const bf16_t* kvm; const bf16_t* proj; bf16_t* km; const float* rope; const float* g_q; const float* g_k; bf16_t* qout; };
template <bool DO_Q> __device__ __forceinline__ void ph_post2(const Post2Args& a, LAS unsigned char* L, int gw, int NGW, int wave, int lane) {
    (void)L; (void)wave;
    const int j = lane & 15, hq = lane >> 4; const bool act = j < 12;
    float gq[8], gk[8];
#pragma unroll
    for (int e = 0; e < 8; ++e) { gq[e] = act ? a.g_q[j * 8 + e] : 0.f; gk[e] = act ? a.g_k[j * 8 + e] : 0.f; }
    u32x4 nq[2], nk[2]; f32x4 nr[4];
#define P2_LOAD(tk) do { const bf16_t* q_ = a.qm + (size_t)(tk) * 768; const bf16_t* kv_ = a.kvm + (size_t)(tk) * 1024; const bf16_t* pe_ = a.proj + (size_t)(tk) * PP + C_KPE; \
        const f32x4* rt_ = (const f32x4*)(a.rope + (size_t)(tk) * ROPE_W + 8 * (j & 1)); \
        _Pragma("unroll") for (int ps = 0; ps < 2; ++ps) { const int h_ = ps * 4 + hq; nq[ps] = (u32x4){0u, 0u, 0u, 0u}; nk[ps] = nq[ps]; \
            if (act) { if (DO_Q) nq[ps] = *(const u32x4*)(q_ + h_ * 96 + 8 * j); nk[ps] = (j < 8) ? *(const u32x4*)(kv_ + 128 * h_ + 8 * j) : *(const u32x4*)(pe_ + 8 * (j - 8)); } } \
        nr[0] = rt_[0]; nr[1] = rt_[1]; nr[2] = rt_[4]; nr[3] = rt_[5]; } while (0)
    if (gw < M) P2_LOAD(gw);
    for (int tok = gw; tok < M; tok += NGW) {
        const u32x4 cq[2] = {nq[0], nq[1]}, ck[2] = {nk[0], nk[1]};
        const float cm[8] = {nr[0].x, nr[0].y, nr[0].z, nr[0].w, nr[1].x, nr[1].y, nr[1].z, nr[1].w}, sm[8] = {nr[2].x, nr[2].y, nr[2].z, nr[2].w, nr[3].x, nr[3].y, nr[3].z, nr[3].w};
        if (tok + NGW < M) P2_LOAD(tok + NGW);
        bf16_t* qrow = a.qout + (size_t)tok * 768; bf16_t* krow = a.km + (size_t)tok * 768;
#pragma unroll
        for (int ps = 0; ps < 2; ++ps) { const int h = ps * 4 + hq;
#pragma unroll
            for (int qk = DO_Q ? 0 : 1; qk < 2; ++qk) { float v[8]; unpack8(qk == 0 ? cq[ps] : ck[ps], v); float s = 0.f;
#pragma unroll
                for (int e = 0; e < 8; ++e) s += v[e] * v[e];
                s += __shfl_xor(s, 1); s += __shfl_xor(s, 2); s += __shfl_xor(s, 4); s += __shfl_xor(s, 8);
                const float r = __builtin_amdgcn_rsqf(s * (1.f / 96.f) + EPS);
#pragma unroll
                for (int e = 0; e < 8; ++e) v[e] *= r * (qk == 0 ? gq[e] : gk[e]);
#pragma unroll
                for (int e = 0; e < 8; ++e) { const float o = __shfl_xor(v[e], 2); if (j >= 8) { if (j < 10) v[e] = v[e] * cm[e] - o * sm[e]; else v[e] = v[e] * cm[e] + o * sm[e]; } }
                if (qk == 0) {
#pragma unroll
                    for (int e = 0; e < 8; ++e) v[e] *= SC_MLA;
                    if (act) *(u32x4*)(qrow + h * 96 + 8 * j) = pack8(v);
                } else if (act) *(u32x4*)(krow + h * 96 + 8 * j) = pack8(v); } }
    }
#undef P2_LOAD
}
__device__ __forceinline__ void ph_headnorm128(bf16_t* X, int R, int pitch, int col0, int nheads, const float* g, float sc, int gw, int NGW, int lane) {
    const int per_row = nheads / 4;
    for (int it = gw; it < R * per_row; it += NGW) {
        const int r = it / per_row, h = (it % per_row) * 4 + (lane >> 4), sub = lane & 15;
        bf16_t* p = X + (size_t)r * pitch + col0 + h * 128 + sub * 8;
        const u32x4 w = *(const u32x4*)p; float v[8] = {bflo(w.x), bfhi(w.x), bflo(w.y), bfhi(w.y), bflo(w.z), bfhi(w.z), bflo(w.w), bfhi(w.w)};
        float s = 0.f;
#pragma unroll
        for (int e = 0; e < 8; ++e) s += v[e] * v[e];
        s += __shfl_xor(s, 1); s += __shfl_xor(s, 2); s += __shfl_xor(s, 4); s += __shfl_xor(s, 8);
        const float rr = sc / sqrtf(s * (1.f / 128.f) + EPS);
#pragma unroll
        for (int e = 0; e < 8; ++e) v[e] *= rr * g[sub * 8 + e];
        u32x4 o; o.x = pk2(v[0], v[1]); o.y = pk2(v[2], v[3]); o.z = pk2(v[4], v[5]); o.w = pk2(v[6], v[7]); *(u32x4*)p = o;
    }
}

struct AttnArgs { const bf16_t* Q; const bf16_t* K; const bf16_t* V; bf16_t* O; const unsigned short* sel;
                  int q_pitch, q_hs, k_pitch, k_hs, v_pitch, v_hs, o_pitch, o_hs, H, kv_group, mode, n_mem; };
template <int DQK, int DV> __device__ __forceinline__ void ph_attn_naive(const AttnArgs& a, LAS unsigned char* L, int gw, int NGW, int wave, int lane) {
    LAS float* qs = (LAS float*)(L + wave * 1024);
    const long total = (long)M * a.H;
    for (long wid = gw; wid < total; wid += NGW) {
        const int row = (int)(wid / a.H), h = (int)(wid % a.H), b = row / SEQ, t = row % SEQ, kvh = h / a.kv_group;
        const bf16_t* q = a.Q + (size_t)row * a.q_pitch + h * a.q_hs;
        __builtin_amdgcn_s_waitcnt(0); __builtin_amdgcn_wave_barrier();
        for (int d = lane; d < DQK; d += 64) qs[d] = bf2f(q[d]);
        __builtin_amdgcn_s_waitcnt(0); __builtin_amdgcn_wave_barrier();
        const int n = a.mode == 0 ? t + 1 : (a.mode == 1 ? a.n_mem : 256);
        const long kbase = a.mode == 1 ? (long)b * a.n_mem : (long)b * SEQ;
        float mrun = -INFINITY, l = 0.f, acc[DV / 64];
#pragma unroll
        for (int i = 0; i < DV / 64; ++i) acc[i] = 0.f;
        for (int c0 = 0; c0 < n; c0 += 64) {
            const int j = c0 + lane; bool valid = j < n; long krow = kbase;
            if (valid) { if (a.mode == 2) { const unsigned idx = a.sel[(size_t)row * 256 + j]; valid = idx != 0xFFFFu && (int)idx <= t; krow = kbase + (valid ? idx : 0); } else krow = kbase + j; }
            float s = -INFINITY;
            if (valid) { const bf16_t* kp = a.K + (size_t)krow * a.k_pitch + kvh * a.k_hs; float d0 = 0.f;
#pragma unroll
                for (int c = 0; c < DQK / 8; ++c) { const u32x4 w = *(const u32x4*)(kp + c * 8); const LAS float* qq = qs + c * 8;
                    d0 += qq[0] * bflo(w.x) + qq[1] * bfhi(w.x) + qq[2] * bflo(w.y) + qq[3] * bfhi(w.y) + qq[4] * bflo(w.z) + qq[5] * bfhi(w.z) + qq[6] * bflo(w.w) + qq[7] * bfhi(w.w); }
                s = d0; }
            const float cmx = wave_max(s);
            if (cmx == -INFINITY) continue;
            const float mnew = fmaxf(mrun, cmx);
            const float alpha = (mrun == -INFINITY) ? 0.f : exp2f(mrun - mnew);
            const float p = valid ? exp2f(s - mnew) : 0.f;
            l = l * alpha + wave_sum(p);
#pragma unroll
            for (int i = 0; i < DV / 64; ++i) acc[i] *= alpha;
            mrun = mnew;
            const int cnt = (n - c0) < 64 ? (n - c0) : 64;
            for (int jj = 0; jj < cnt; ++jj) {
                const float pj = __shfl(p, jj); const long rj = __shfl((int)(krow - kbase), jj) + kbase;
                if (pj != 0.f) { const bf16_t* vp = a.V + (size_t)rj * a.v_pitch + kvh * a.v_hs;
#pragma unroll
                    for (int i = 0; i < DV / 64; ++i) acc[i] += pj * bf2f(vp[lane + 64 * i]); }
            }
        }
        bf16_t* o = a.O + (size_t)row * a.o_pitch + h * a.o_hs;
        const float il = 1.0f / l;
#pragma unroll
        for (int i = 0; i < DV / 64; ++i) o[lane + 64 * i] = (bf16_t)f2bf(acc[i] * il);
    }
}

__device__ __forceinline__ unsigned mono_key(float s) { const unsigned u = __builtin_bit_cast(unsigned, s + 0.0f); return (u & 0x80000000u) ? ~u : (u | 0x80000000u); }
__device__ __forceinline__ void ph_index_naive(const bf16_t* proj, const bf16_t* Ki, const float* Wi, unsigned short* SEL, LAS unsigned char* L, int bid, int G) {
    LAS unsigned* keys = (LAS unsigned*)L;
    LAS float* qs = (LAS float*)(L + 32768);
    LAS float* wsm = (LAS float*)(L + 32768 + 2048);
    LAS int* red = (LAS int*)(L + 32768 + 2048 + 64);
    LAS int* cgt = (LAS int*)(L + 36864);
    LAS int* ceq = cgt + 512;
    const int tid = tid_opaque(), lane = tid & 63, wave = tid >> 6;
    for (int row = bid; row < M; row += G) {
        const int b = row / SEQ, t = row % SEQ, n = t + 1;
        unsigned short* out = SEL + (size_t)row * 256;
        if (n <= 256) { if (tid < 256) out[tid] = tid < n ? (unsigned short)tid : (unsigned short)0xFFFFu; continue; }
        __syncthreads();
        qs[tid] = bf2f(proj[(size_t)row * PP + C_QI + tid]);
        if (tid < 8) wsm[tid] = Wi[(size_t)row * 8 + tid];
        __syncthreads();
        for (int j = tid; j < n; j += NTHREADS) {
            const bf16_t* kp = Ki + ((size_t)b * SEQ + j) * 64; float d[8];
#pragma unroll
            for (int h = 0; h < 8; ++h) d[h] = 0.f;
#pragma unroll 1
            for (int c = 0; c < 8; ++c) { const u32x4 w = *(const u32x4*)(kp + c * 8);
                const float k0 = bflo(w.x), k1 = bfhi(w.x), k2 = bflo(w.y), k3 = bfhi(w.y), k4 = bflo(w.z), k5 = bfhi(w.z), k6 = bflo(w.w), k7 = bfhi(w.w);
#pragma unroll
                for (int h = 0; h < 8; ++h) { const LAS float* qq = qs + h * 64 + c * 8;
                    d[h] += qq[0] * k0 + qq[1] * k1 + qq[2] * k2 + qq[3] * k3 + qq[4] * k4 + qq[5] * k5 + qq[6] * k6 + qq[7] * k7; } }
            float sc = 0.f;
#pragma unroll
            for (int h = 0; h < 8; ++h) sc += wsm[h] * fmaxf(d[h], 0.f);
            keys[j] = mono_key(sc);
        }
        __syncthreads();
        unsigned T = 0u;
        for (int bit = 31; bit >= 0; --bit) {
            const unsigned cand = T | (1u << bit); int c = 0;
            for (int j = tid; j < n; j += NTHREADS) c += keys[j] >= cand ? 1 : 0;
#pragma unroll
            for (int o = 1; o < 64; o <<= 1) c += __shfl_xor(c, o);
            if (lane == 0) red[(bit & 1) * 8 + wave] = c;
            __syncthreads();
            int tot = 0;
#pragma unroll
            for (int w = 0; w < 8; ++w) tot += red[(bit & 1) * 8 + w];
            if (tot >= 256) T = cand;
        }
        const int j0 = tid * 16; int ngt = 0, neq = 0;
        for (int j = j0; j < j0 + 16 && j < n; ++j) { const unsigned k = keys[j]; ngt += k > T; neq += k == T; }
        cgt[tid] = ngt; ceq[tid] = neq;
        __syncthreads();
        int tot_gt = 0; for (int i = 0; i < NTHREADS; ++i) tot_gt += cgt[i];
        const int r = 256 - tot_gt;
        int pe = 0, off = 0;
        for (int i = 0; i < tid; ++i) { const int rem = r - pe; const int take = rem <= 0 ? 0 : (ceq[i] < rem ? ceq[i] : rem); off += cgt[i] + take; pe += ceq[i]; }
        for (int j = j0; j < j0 + 16 && j < n; ++j) { const unsigned k = keys[j];
            if (k > T) out[off++] = (unsigned short)j; else if (k == T) { if (pe < r) out[off++] = (unsigned short)j; ++pe; } }
    }
    __syncthreads();
}


struct EpiProj {
    static constexpr bool PERM = true, AFTER_DRAIN = false;
    int pad;
    __device__ __forceinline__ void operator()(const pg8::f32x4 (&acc)[2][2][4][2], const pg8::Unit& u, int wr, int wc, int fr, int fq) const {
        typedef float f32x2 __attribute__((ext_vector_type(2)));
        asm volatile("" : "+v"(fr), "+v"(fq));
        unsigned char* ws = P_WS;
        const int T = u.pn;
        bool do_norm = false, do_rope = false, misc = false; float scale = 1.f; const float* g = nullptr; float* ssq = nullptr;
        bf16_t* dst = (bf16_t*)(ws + WS_PROJ); int pitch = PP, col0 = 0;
        if (T == 0) { ssq = (float*)(ws + WS_SSQ_CQ); col0 = C_CQ + 64 * wc; }
        else if (T == 1) {
            if (wc < 2) { ssq = (float*)(ws + WS_SSQ_CKV); col0 = C_CKV + 64 * wc; }
            else if (wc == 2) { misc = true; col0 = C_KPE; }
            else { do_norm = true; do_rope = true; g = P_IN(13); dst = (bf16_t*)(ws + WS_KI); pitch = 64; col0 = 0; } }
        else if (T < 4) { do_norm = true; do_rope = true; g = P_IN(11); scale = SC_DSA; col0 = C_QD + 64 * (4 * (T - 2) + wc); }
        else if (T < 6) { do_rope = true; scale = SC_IDX; col0 = C_QI + 64 * (4 * (T - 4) + wc); }
        else { dst = (bf16_t*)(ws + WS_KVD); pitch = 256; if (wc < 2) { do_norm = true; do_rope = true; g = P_IN(12); col0 = 64 * wc; } else col0 = 128 + 64 * (wc - 2); }
        const int row0 = u.pm * pg8::BM + wr * 64 + fr;
        float g0[8], g1[8];
        if (do_norm) { const f32x2 a = *(const f32x2*)(g + 2 * fq), b = *(const f32x2*)(g + 8 + 2 * fq); const f32x4 c = *(const f32x4*)(g + 16 + 4 * fq), d = *(const f32x4*)(g + 32 + 8 * fq), e = *(const f32x4*)(g + 36 + 8 * fq);
            g0[0] = a.x; g0[1] = a.y; g0[2] = b.x; g0[3] = b.y; g0[4] = c.x; g0[5] = c.y; g0[6] = c.z; g0[7] = c.w; g1[0] = d.x; g1[1] = d.y; g1[2] = d.z; g1[3] = d.w; g1[4] = e.x; g1[5] = e.y; g1[6] = e.z; g1[7] = e.w; }
        f32x2 rc[8], rs[8];
        if (do_rope) { const float* rt = (const float*)(ws + WS_ROPE) + 32 + 2 * fq;
#pragma unroll
            for (int i = 0; i < 8; ++i) { const float* rr = rt + (size_t)(row0 + (i >> 2) * pg8::HALF + (i & 3) * 16) * ROPE_W; rc[i] = *(const f32x2*)rr; rs[i] = *(const f32x2*)(rr + 8); } }
#pragma unroll
        for (int ai = 0; ai < 2; ++ai)
#pragma unroll
            for (int m = 0; m < 4; ++m) { const int row = row0 + ai * pg8::HALF + m * 16;
                float v[16];
#pragma unroll
                for (int e = 0; e < 4; ++e) { v[e] = acc[ai][0][m][0][e]; v[4 + e] = acc[ai][0][m][1][e]; v[8 + e] = acc[ai][1][m][0][e]; v[12 + e] = acc[ai][1][m][1][e]; }
                if (ssq != nullptr || do_norm) { float ss = 0.f;
#pragma unroll
                    for (int e = 0; e < 16; ++e) ss += v[e] * v[e];
                    ss += __shfl_xor(ss, 16); ss += __shfl_xor(ss, 32);
                    if (ssq != nullptr) { if (fq == 0) (void)__builtin_amdgcn_global_atomic_fadd_f32((__attribute__((address_space(1))) float*)(ssq + row), ss); }
                    else { const float r = __builtin_amdgcn_rsqf(ss * (1.f / 64.f) + EPS);
#pragma unroll
                        for (int e = 0; e < 8; ++e) { v[e] *= r * g0[e]; v[8 + e] *= r * g1[e]; } } }
                if (do_rope) { const f32x2 c = rc[ai * 4 + m], s = rs[ai * 4 + m];
                    const float a0 = v[0] * c.x - v[2] * s.x, b0 = v[2] * c.x + v[0] * s.x, a1 = v[1] * c.y - v[3] * s.y, b1 = v[3] * c.y + v[1] * s.y;
                    v[0] = a0; v[2] = b0; v[1] = a1; v[3] = b1; }
                if (misc) {
                    { float sp = 0.f;
#pragma unroll
                      for (int q = 0; q < 8; ++q) sp += v[q] * v[q];
                      sp += __shfl_xor(sp, 16); sp += __shfl_xor(sp, 32); if (fq == 0) ((float*)(ws + WS_SS_PE))[row] = sp; }
                    u32x4 w; w.x = pg8::cvt_pk_bf16(v[0], v[1]); w.y = pg8::cvt_pk_bf16(v[2], v[3]); w.z = pg8::cvt_pk_bf16(v[4], v[5]); w.w = pg8::cvt_pk_bf16(v[6], v[7]);
                    *(u32x4*)(dst + (size_t)row * PP + C_KPE + 8 * fq) = w;
                    if (fq == 0) { float* wp = (float*)(ws + WS_WI) + (size_t)row * 8; const float k = 0.35355339059327373f;
                        *(f32x4*)wp = (f32x4){v[8] * k, v[9] * k, v[10] * k, v[11] * k}; *(f32x4*)(wp + 4) = (f32x4){v[12] * k, v[13] * k, v[14] * k, v[15] * k}; }
                } else {
                    u32x4 w0, w1;
                    w0.x = pg8::cvt_pk_bf16(v[0] * scale, v[1] * scale); w0.y = pg8::cvt_pk_bf16(v[2] * scale, v[3] * scale); w0.z = pg8::cvt_pk_bf16(v[4] * scale, v[5] * scale); w0.w = pg8::cvt_pk_bf16(v[6] * scale, v[7] * scale);
                    w1.x = pg8::cvt_pk_bf16(v[8] * scale, v[9] * scale); w1.y = pg8::cvt_pk_bf16(v[10] * scale, v[11] * scale); w1.z = pg8::cvt_pk_bf16(v[12] * scale, v[13] * scale); w1.w = pg8::cvt_pk_bf16(v[14] * scale, v[15] * scale);
                    bf16_t* rp = dst + (size_t)row * pitch + col0 + 8 * fq;
                    *(u32x4*)rp = w0; *(u32x4*)(rp + 32) = w1; }
            }
    }
};

struct EpiKV {
    static constexpr bool PERM = true, AFTER_DRAIN = false;
    int pad;
    __device__ __forceinline__ void operator()(const pg8::f32x4 (&acc)[2][2][4][2], const pg8::Unit& u, int wr, int wc, int fr, int fq) const {
        asm volatile("" : "+v"(fr), "+v"(fq));
        unsigned char* ws = P_WS;
        const int h = 2 * u.pn + (wc >> 1); const bool isv = (wc & 1) != 0;
        const int row0 = u.pm * pg8::BM + wr * 64 + fr;
        const float* ssq = (const float*)(ws + WS_SSQ_CKV);
        float rck[8];
#pragma unroll
        for (int i = 0; i < 8; ++i) rck[i] = ssq[row0 + (i >> 2) * pg8::HALF + (i & 3) * 16];
        if (isv) {
            bf16_t* dst = (bf16_t*)(ws + WS_KVM) + 128 * h + 64 + 8 * fq;
#pragma unroll
            for (int ai = 0; ai < 2; ++ai)
#pragma unroll
                for (int m = 0; m < 4; ++m) { const int row = row0 + ai * pg8::HALF + m * 16; const float rs = __builtin_amdgcn_rsqf(rck[ai * 4 + m] * (1.f / 128.f) + EPS);
                    const pg8::f32x4 a0 = acc[ai][0][m][0] * rs, a1 = acc[ai][0][m][1] * rs, b0 = acc[ai][1][m][0] * rs, b1 = acc[ai][1][m][1] * rs;
                    u32x4 w0, w1; w0.x = pg8::cvt_pk_bf16(a0[0], a0[1]); w0.y = pg8::cvt_pk_bf16(a0[2], a0[3]); w0.z = pg8::cvt_pk_bf16(a1[0], a1[1]); w0.w = pg8::cvt_pk_bf16(a1[2], a1[3]);
                    w1.x = pg8::cvt_pk_bf16(b0[0], b0[1]); w1.y = pg8::cvt_pk_bf16(b0[2], b0[3]); w1.z = pg8::cvt_pk_bf16(b1[0], b1[1]); w1.w = pg8::cvt_pk_bf16(b1[2], b1[3]);
                    bf16_t* rp = dst + (size_t)row * 1024; *(u32x4*)rp = w0; *(u32x4*)(rp + 32) = w1; }
        } else {
            const float* g = P_IN(10); const float* spe = (const float*)(ws + WS_SS_PE);
            float sp[8];
#pragma unroll
            for (int i = 0; i < 8; ++i) sp[i] = spe[row0 + (i >> 2) * pg8::HALF + (i & 3) * 16];
            bf16_t* km = (bf16_t*)(ws + WS_KM) + 96 * h;
            float rr[8];
            { const f32x4 ga = *(const f32x4*)(g + 8 * fq), gb = *(const f32x4*)(g + 8 * fq + 4), gc = *(const f32x4*)(g + 32 + 8 * fq), gd = *(const f32x4*)(g + 36 + 8 * fq);
#pragma unroll
              for (int i = 0; i < 8; ++i) { const int ai = i >> 2, m = i & 3; const int row = row0 + ai * pg8::HALF + m * 16; const float rs = __builtin_amdgcn_rsqf(rck[i] * (1.f / 128.f) + EPS);
                const pg8::f32x4 a0 = acc[ai][0][m][0] * rs, a1 = acc[ai][0][m][1] * rs, b0 = acc[ai][1][m][0] * rs, b1 = acc[ai][1][m][1] * rs;
                float ss = ((a0[0] * a0[0] + a0[1] * a0[1]) + (a0[2] * a0[2] + a0[3] * a0[3])) + ((a1[0] * a1[0] + a1[1] * a1[1]) + (a1[2] * a1[2] + a1[3] * a1[3]))
                         + ((b0[0] * b0[0] + b0[1] * b0[1]) + (b0[2] * b0[2] + b0[3] * b0[3])) + ((b1[0] * b1[0] + b1[1] * b1[1]) + (b1[2] * b1[2] + b1[3] * b1[3]));
                ss += __shfl_xor(ss, 16); ss += __shfl_xor(ss, 32);
                const float r = __builtin_amdgcn_rsqf((ss + sp[i]) * (1.f / 96.f) + EPS); rr[i] = r;
                const pg8::f32x4 o0 = a0 * ga * r, o1 = a1 * gb * r, o2 = b0 * gc * r, o3 = b1 * gd * r;
                u32x4 w0, w1; w0.x = pg8::cvt_pk_bf16(o0[0], o0[1]); w0.y = pg8::cvt_pk_bf16(o0[2], o0[3]); w0.z = pg8::cvt_pk_bf16(o1[0], o1[1]); w0.w = pg8::cvt_pk_bf16(o1[2], o1[3]);
                w1.x = pg8::cvt_pk_bf16(o2[0], o2[1]); w1.y = pg8::cvt_pk_bf16(o2[2], o2[3]); w1.z = pg8::cvt_pk_bf16(o3[0], o3[1]); w1.w = pg8::cvt_pk_bf16(o3[2], o3[3]);
                bf16_t* rp = km + (size_t)row * 768; *(u32x4*)(rp + 8 * fq) = w0; *(u32x4*)(rp + 32 + 8 * fq) = w1; } }
            __builtin_amdgcn_sched_barrier(0);
            { int fq2 = fq, fr2 = fr; asm volatile("" : "+v"(fq2), "+v"(fr2));
              const int row2 = u.pm * pg8::BM + wr * 64 + fr2;
              const f32x4 gp1 = *(const f32x4*)(g + 64 + 4 * fq2), gp2 = *(const f32x4*)(g + 80 + 4 * fq2);
              const bf16_t* pe = (const bf16_t*)(ws + WS_PROJ) + C_KPE + 4 * fq2; const float* rt = (const float*)(ws + WS_ROPE) + 4 * fq2;
              u32x2 x1[8], x2[8]; f32x4 cs[8], sn[8];
#pragma unroll
              for (int i = 0; i < 8; ++i) { const size_t r_ = (size_t)(row2 + (i >> 2) * pg8::HALF + (i & 3) * 16); x1[i] = *(const u32x2*)(pe + r_ * PP); x2[i] = *(const u32x2*)(pe + r_ * PP + 16); cs[i] = *(const f32x4*)(rt + r_ * ROPE_W); sn[i] = *(const f32x4*)(rt + r_ * ROPE_W + 16); }
#pragma unroll
              for (int i = 0; i < 8; ++i) { const int row = row2 + (i >> 2) * pg8::HALF + (i & 3) * 16; const float r = rr[i];
                const f32x4 y1 = (f32x4){bflo(x1[i].x), bfhi(x1[i].x), bflo(x1[i].y), bfhi(x1[i].y)} * gp1 * r, y2 = (f32x4){bflo(x2[i].x), bfhi(x2[i].x), bflo(x2[i].y), bfhi(x2[i].y)} * gp2 * r;
                const f32x4 p1 = y1 * cs[i] - y2 * sn[i], p2 = y2 * cs[i] + y1 * sn[i];
                u32x2 q1, q2; q1.x = pg8::cvt_pk_bf16(p1[0], p1[1]); q1.y = pg8::cvt_pk_bf16(p1[2], p1[3]); q2.x = pg8::cvt_pk_bf16(p2[0], p2[1]); q2.y = pg8::cvt_pk_bf16(p2[2], p2[3]);
                bf16_t* rp = km + (size_t)row * 768; *(u32x2*)(rp + 64 + 4 * fq2) = q1; *(u32x2*)(rp + 80 + 4 * fq2) = q2; } }
        }
    }
};


namespace fa {
typedef short bf16x8 __attribute__((ext_vector_type(8)));
typedef short s16x4 __attribute__((ext_vector_type(4)));
typedef float f32x16 __attribute__((ext_vector_type(16)));
typedef __attribute__((address_space(3))) const char* lds_cptr;
struct CfgMLA   { static constexpr int DQK = 96,  DV = 64,  QP = 768, KP = 768,  VP = 1024, OP = 1024, QHS = 96,  KHS = 96,  VHS = 128, OHS = 64;  static constexpr bool CAUSAL = true,  QNORM = false; };
struct CfgCross { static constexpr int DQK = 128, DV = 128, QP = 512, KP = 1024, VP = 1024, OP = 512,  QHS = 128, KHS = 128, VHS = 128, OHS = 128; static constexpr bool CAUSAL = false, QNORM = true;  };
__device__ __forceinline__ int crow(int r, int hi) { return (r & 3) + 8 * (r >> 2) + 4 * hi; }
__device__ __forceinline__ void glds16(const void* g, unsigned lds_dst) { unsigned sv;
    asm volatile("s_mov_b32 %0, m0\n\ts_mov_b32 m0, %2\n\ts_nop 0\n\tglobal_load_lds_dwordx4 %1, off\n\ts_mov_b32 m0, %0" : "=&s"(sv) : "v"(g), "s"(lds_dst) : "memory"); }
__device__ __forceinline__ s16x4 vtr(lds_cptr p) { typedef short v4i16_t __attribute__((ext_vector_type(4))); return __builtin_bit_cast(s16x4, __builtin_amdgcn_ds_read_tr16_b64_v4i16((__attribute__((address_space(3))) v4i16_t*)p)); }
__device__ __forceinline__ unsigned cvtpk(float lo, float hi) { typedef float f2 __attribute__((ext_vector_type(2))); typedef __bf16 b2 __attribute__((ext_vector_type(2))); f2 v = {lo, hi}; b2 b = __builtin_convertvector(v, b2); return __builtin_bit_cast(unsigned, b); }
#define MLA_WAIT_BAR() asm volatile("s_waitcnt vmcnt(0) lgkmcnt(0)\n\ts_barrier" ::: "memory")

template <class C, int THR> __device__ __forceinline__ void unit(long q_row0, long kv_row0, int h, int NT, const bf16_t* Q, const bf16_t* K, const bf16_t* V, bf16_t* O, LAS unsigned char* L, const float* qgain = nullptr, float qscale = 1.f) {
    constexpr int DQK = C::DQK, DV = C::DV, QP = C::QP, KP = C::KP, VP = C::VP, OP = C::OP, NKC = DQK / 8, NDB = DV / 32;
    constexpr int KSLOT = NKC * 1024, VSLOT = NDB * 4096, SLOT = KSLOT + VSLOT, NSLOT = 3, LDS_WS = NSLOT * SLOT, LDS_OST = 0  ;
    static_assert(LDS_WS + 8 * 256 <= RING_BYTES && 8 * 32 * DV * 2 <= NSLOT * SLOT, "fa lds");
    const int tid = tid_opaque(), lane = tid & 63, r32 = lane & 31, hi = lane >> 5; const int wid = __builtin_amdgcn_readfirstlane(tid >> 6);
    const bf16_t* Qw = Q + (q_row0 + wid * 32) * QP + h * C::QHS;
    const bf16_t* Kh = K + kv_row0 * KP + h * C::KHS; const bf16_t* Vh = V + kv_row0 * VP + h * C::VHS;
    const unsigned lds0 = (unsigned)(uintptr_t)L;
    LAS float* wsf = (LAS float*)(L + LDS_WS) + wid * 64;
    const bf16_t* ksrc0 = Kh + (long)lane * KP + wid * 8; const bf16_t* ksrc1 = ksrc0 + 64;
    const bf16_t* vsrc = Vh + (long)(16 * (wid & 3) + (lane >> 2)) * VP + (wid >> 2) * 32 + (lane & 3) * 8;
    const unsigned kdst0 = lds0 + wid * 1024, kdst1 = kdst0 + 8192, vdst = lds0 + KSLOT + wid * 1024;
#define MLA_DMA(t, slot) do { glds16(ksrc0 + (long)(t) * 64 * KP, (unsigned)__builtin_amdgcn_readfirstlane(kdst0 + (slot))); \
        if (8 + wid < NKC) glds16(ksrc1 + (long)(t) * 64 * KP, (unsigned)__builtin_amdgcn_readfirstlane(kdst1 + (slot))); \
        glds16(vsrc + (long)(t) * 64 * VP, (unsigned)__builtin_amdgcn_readfirstlane(vdst + (slot))); \
        if (NDB == 4) glds16(vsrc + (long)(t) * 64 * VP + 64, (unsigned)__builtin_amdgcn_readfirstlane(vdst + 8192 + (slot))); } while (0)
    const lds_cptr kp0 = (lds_cptr)L + hi * 1024 + r32 * 16;
    const lds_cptr vp0 = (lds_cptr)L + KSLOT + ((lane >> 4) & 1) * 32 + (lane & 3) * 8 + (4 * hi + ((lane & 15) >> 2)) * 64;
    MLA_DMA(0, 0); if (NT > 1) MLA_DMA(1, SLOT);
    bf16x8 qr[DQK / 16];
#pragma unroll
    for (int d0 = 0; d0 < DQK / 16; ++d0) qr[d0] = *reinterpret_cast<const bf16x8*>(Qw + (long)r32 * QP + d0 * 16 + hi * 8);
    if constexpr (C::QNORM) {
        float sq = 0.f;
#pragma unroll
        for (int d0 = 0; d0 < DQK / 16; ++d0)
#pragma unroll
            for (int j = 0; j < 8; ++j) { const float x = __builtin_bit_cast(float, (unsigned)(unsigned short)qr[d0][j] << 16); sq += x * x; }
        { auto rr = __builtin_amdgcn_permlane32_swap(__float_as_uint(sq), __float_as_uint(sq), false, false); sq = __uint_as_float(rr[0]) + __uint_as_float(rr[1]); }
        const float rs = qscale * __builtin_amdgcn_rsqf(sq * (1.0f / DQK) + EPS);
#pragma unroll
        for (int d0 = 0; d0 < DQK / 16; ++d0) { const f32x4 g0 = *(const f32x4*)(qgain + 16 * d0 + 8 * hi), g1 = *(const f32x4*)(qgain + 16 * d0 + 8 * hi + 4); float x[8];
#pragma unroll
            for (int j = 0; j < 8; ++j) x[j] = __builtin_bit_cast(float, (unsigned)(unsigned short)qr[d0][j] << 16) * rs * (j < 4 ? g0[j] : g1[j - 4]);
            typedef unsigned u4 __attribute__((ext_vector_type(4)));
            u4 w; w.x = cvtpk(x[0], x[1]); w.y = cvtpk(x[2], x[3]); w.z = cvtpk(x[4], x[5]); w.w = cvtpk(x[6], x[7]); qr[d0] = __builtin_bit_cast(bf16x8, w); }
    }
    float mrow = -INFINITY, l0 = 0.f, l1 = 0.f, l2 = 0.f, l3 = 0.f; f32x16 o[NDB];
#pragma unroll
    for (int d0 = 0; d0 < NDB; ++d0) o[d0] = f32x16{};
    const int qrel = wid * 32 + r32;
    const int ndma = 1 + ((8 + wid < NKC) ? 1 : 0) + (NDB == 4 ? 2 : 1);
#define MLA_WAIT_KEEP(cond_keep) do { if (cond_keep) { if (ndma == 2) asm volatile("s_waitcnt vmcnt(2) lgkmcnt(0)\n\ts_barrier" ::: "memory"); else if (ndma == 3) asm volatile("s_waitcnt vmcnt(3) lgkmcnt(0)\n\ts_barrier" ::: "memory"); else asm volatile("s_waitcnt vmcnt(4) lgkmcnt(0)\n\ts_barrier" ::: "memory"); } else MLA_WAIT_BAR(); } while (0)
    MLA_WAIT_BAR();
#define FA_BLOCK_A(HN) do { bf16x8 kfr[KD]; if (HN) { _Pragma("unroll") for (int g_ = 0; g_ < KD; ++g_) kfr[g_] = FA_KLD((g_ >> 1) * 2048 + (g_ & 1) * 512); } _Pragma("unroll") for (int g = 0; g < NG; ++g) { if (HN) { const int d0 = g >> 1; const bf16x8 kf = kfr[g % KD]; if (g + KD < NG) kfr[g % KD] = FA_KLD(((g + KD) >> 1) * 2048 + ((g + KD) & 1) * 512); if (g & 1) pn1 = __builtin_amdgcn_mfma_f32_32x32x16_bf16(kf, qr[d0], pn1, 0, 0, 0); else pn0 = __builtin_amdgcn_mfma_f32_32x32x16_bf16(kf, qr[d0], pn0, 0, 0, 0); } if (g < 8) { _Pragma("unroll") for (int e = 0; e < 4; ++e) { const int r = (4 * g + e) & 15; if (g < 4) pc0[r] = __builtin_amdgcn_exp2f(pc0[r] - mrow); else pc1[r] = __builtin_amdgcn_exp2f(pc1[r] - mrow); } if (g < 4) FA_PIN(pc0); else FA_PIN(pc1); } else if (g < 12) { const int ks = g - 8, bb = (ks & 1) * 8; const f32x16& P = (ks < 2) ? pc0 : pc1; FA_ADD(l0, P[bb + 0]); FA_ADD(l1, P[bb + 1]); FA_ADD(l2, P[bb + 2]); FA_ADD(l3, P[bb + 3]); FA_ADD(l0, P[bb + 4]); FA_ADD(l1, P[bb + 5]); FA_ADD(l2, P[bb + 6]); FA_ADD(l3, P[bb + 7]); typedef unsigned u4 __attribute__((ext_vector_type(4))); u4 w; w.x = cvtpk(P[bb + 0], P[bb + 1]); w.y = cvtpk(P[bb + 2], P[bb + 3]); w.z = cvtpk(P[bb + 4], P[bb + 5]); w.w = cvtpk(P[bb + 6], P[bb + 7]); pa[ks] = __builtin_bit_cast(bf16x8, w); FA_PIN(pa[ks]); } FA_SB(); } } while (0)
#define FA_PIN(x) asm volatile("" : "+v"(x))
#define FA_ADD(acc, x) asm("v_add_f32 %0, %0, %1" : "+v"(acc) : "v"(x))
#define FA_SB() __builtin_amdgcn_sched_barrier(0)
#define FA_KLD(off) (*(const __attribute__((address_space(3))) bf16x8*)(kpn + (off)))
#define FA_MASK(P0, P1, tt) do { const int jb_ = (tt) - (NT - 4); if (C::CAUSAL && jb_ >= 0) { const int kb_ = 64 * jb_ + 4 * hi; \
        _Pragma("unroll") for (int r = 0; r < 16; ++r) { const int kv = kb_ + (r & 3) + 8 * (r >> 2); if (kv > qrel) P0[r] = -INFINITY; if (kv + 32 > qrel) P1[r] = -INFINITY; } } } while (0)
#define FA_DECIDE(RM) do { float rm_ = (RM); { auto rr = __builtin_amdgcn_permlane32_swap(__float_as_uint(rm_), __float_as_uint(rm_), false, false); rm_ = fmaxf(__uint_as_float(rr[0]), __uint_as_float(rr[1])); } \
        if (__any(rm_ > mrow + (float)THR)) { const float mnew = fmaxf(mrow, rm_); const float alpha = __builtin_amdgcn_exp2f(mrow - mnew); mrow = mnew; l0 *= alpha; l1 *= alpha; l2 *= alpha; l3 *= alpha; \
            if (hi == 0) wsf[r32] = alpha; asm volatile("s_waitcnt lgkmcnt(0)" ::: "memory"); \
            _Pragma("unroll") for (int r = 0; r < 16; ++r) { const float f = wsf[crow(r, hi)]; _Pragma("unroll") for (int d0 = 0; d0 < NDB; ++d0) o[d0][r] *= f; } } } while (0)
    constexpr int NG = DQK / 8, NPV = NDB * 4, KD = 4, VD = 3;
    int slot = 0, slot2 = 2 * SLOT;
    f32x16 pc0, pc1;
    { const lds_cptr kpn = kp0;
      pc0 = f32x16{}; pc1 = f32x16{};
#pragma unroll
      for (int d0 = 0; d0 < DQK / 16; ++d0) { pc0 = __builtin_amdgcn_mfma_f32_32x32x16_bf16(FA_KLD(d0 * 2048), qr[d0], pc0, 0, 0, 0); pc1 = __builtin_amdgcn_mfma_f32_32x32x16_bf16(FA_KLD(d0 * 2048 + 512), qr[d0], pc1, 0, 0, 0); }
      FA_MASK(pc0, pc1, 0);
      float rma = fmaxf(pc0[0], pc1[0]);
#pragma unroll
      for (int r = 1; r < 16; ++r) rma = fmaxf(rma, fmaxf(pc0[r], pc1[r]));
      FA_DECIDE(rma); }
    for (int t = 0; t < NT; ++t) {
        if (t + 2 < NT) MLA_DMA(t + 2, slot2);
        const bool has_next = t + 1 < NT;
        const lds_cptr kpn = kp0 + ((slot == 2 * SLOT) ? 0 : slot + SLOT);
        f32x16 pn0 = f32x16{}, pn1 = f32x16{}; bf16x8 pa[4];
        FA_SB();
        if (has_next) FA_BLOCK_A(true); else FA_BLOCK_A(false);
        if (has_next) FA_MASK(pn0, pn1, t + 1);
        const lds_cptr vp = vp0 + slot;
        float rma = -INFINITY, rmb = -INFINITY;
        FA_SB();
        s16x4 vlo[VD], vhh[VD];
#pragma unroll
        for (int i = 0; i < VD; ++i) { vlo[i] = vtr(vp + (i >> 2) * 4096 + (i & 3) * 1024); vhh[i] = vtr(vp + (i >> 2) * 4096 + (i & 3) * 1024 + 512); }
#pragma unroll
        for (int i = 0; i < NPV; ++i) { const int d0 = i >> 2, ks = i & 3;
            const bf16x8 vf = (bf16x8){vlo[i % VD][0], vlo[i % VD][1], vlo[i % VD][2], vlo[i % VD][3], vhh[i % VD][0], vhh[i % VD][1], vhh[i % VD][2], vhh[i % VD][3]};
            if (i + VD < NPV) { const int d1 = (i + VD) >> 2, k1 = (i + VD) & 3; vlo[i % VD] = vtr(vp + d1 * 4096 + k1 * 1024); vhh[i % VD] = vtr(vp + d1 * 4096 + k1 * 1024 + 512); }
            o[d0] = __builtin_amdgcn_mfma_f32_32x32x16_bf16(pa[ks], vf, o[d0], 0, 0, 0);
            if (i < 8) { rma = fmaxf(rma, fmaxf(pn0[2 * i], pn1[2 * i])); rmb = fmaxf(rmb, fmaxf(pn0[2 * i + 1], pn1[2 * i + 1])); FA_PIN(rma); FA_PIN(rmb); }
            FA_SB();
        }
        if (has_next) FA_DECIDE(fmaxf(rma, rmb));
        MLA_WAIT_BAR();
        pc0 = pn0; pc1 = pn1;
        slot2 = slot; slot = (slot == 2 * SLOT) ? 0 : slot + SLOT;
    }
#undef FA_PIN
#undef FA_ADD
#undef FA_BLOCK_A
#undef FA_SB
#undef FA_KLD
#undef FA_MASK
#undef FA_DECIDE
    float lsum = (l0 + l1) + (l2 + l3);
    { auto rr = __builtin_amdgcn_permlane32_swap(__float_as_uint(lsum), __float_as_uint(lsum), false, false); lsum = __uint_as_float(rr[0]) + __uint_as_float(rr[1]); }
    if (hi == 0) wsf[32 + r32] = lsum;
    asm volatile("s_waitcnt lgkmcnt(0)" ::: "memory");
    float rli[16];
#pragma unroll
    for (int r = 0; r < 16; ++r) rli[r] = __builtin_amdgcn_rcpf(wsf[32 + crow(r, hi)]);
    bf16_t* Ow = O + (q_row0 + wid * 32) * OP + h * C::OHS;
    { LAS bf16_t* stg = (LAS bf16_t*)(L + LDS_OST) + wid * (32 * DV);
#pragma unroll
      for (int r = 0; r < 16; ++r) { const int orow = crow(r, hi);
#pragma unroll
          for (int d0 = 0; d0 < NDB; ++d0) stg[orow * DV + d0 * 32 + r32] = (bf16_t)f2bf(o[d0][r] * rli[r]); }
      asm volatile("s_waitcnt lgkmcnt(0)" ::: "memory");
      constexpr int CPR = DV / 8;
#pragma unroll
      for (int i = 0; i < 32 * CPR / 64; ++i) { const int row = i * (64 / CPR) + lane / CPR, ch = lane % CPR; const u32x4 v = *(const LAS u32x4*)(stg + row * DV + ch * 8); *(u32x4*)(Ow + (long)row * OP + ch * 8) = v; } }
    asm volatile("s_waitcnt lgkmcnt(0)\n\ts_barrier" ::: "memory");
#undef MLA_DMA
#undef MLA_WAIT_KEEP
}
template <int THR> __device__ __forceinline__ void mla_phase(const bf16_t* Q, const bf16_t* K, const bf16_t* V, bf16_t* O, LAS unsigned char* L, int G, int bid) {
    if (G == 256) {
        const int vcu = (bid % 8) * (G / 8) + bid / 8, s = vcu & 7, bh = vcu >> 3;
        for (int i = 0; i < 4; ++i) { const int qb = (i == 0) ? s : (i == 1) ? 15 - s : (i == 2) ? 16 + s : 31 - s; const long rb = (long)(bh / 8) * SEQ;
            unit<CfgMLA, THR>(rb + qb * 256, rb, bh % 8, 4 * qb + 4, Q, K, V, O, L); }
    } else {
        for (int u = bid; u < BATCH * 8 * 32; u += G) { const long rb = (long)(u / 256) * SEQ; const int qb = u % 32; unit<CfgMLA, THR>(rb + qb * 256, rb, (u / 32) % 8, 4 * qb + 4, Q, K, V, O, L); }
    }
}
template <int THR> __device__ __forceinline__ void cross_phase(const bf16_t* Q, const bf16_t* K, const bf16_t* V, bf16_t* O, const float* qgain, LAS unsigned char* L, int G, int bid) {
    if (G == 256) {
        const int mt = 16 * (bid & 7) + (bid >> 4), b = mt >> 5, qb = mt & 31, h0 = ((bid >> 3) & 1) * 2;
        for (int hh = 0; hh < 2; ++hh) unit<CfgCross, THR>((long)b * SEQ + qb * 256, (long)b * NMEM, h0 + hh, NMEM / 64, Q, K, V, O, L, qgain, SC_MEM);
    } else {
    for (int u = bid; u < BATCH * 4 * 32; u += G) { const int b = u / 128, h = (u / 32) % 4, qb = u % 32;
        unit<CfgCross, THR>((long)b * SEQ + qb * 256, (long)b * NMEM, h, NMEM / 64, Q, K, V, O, L, qgain, SC_MEM); }
    }
}
}


namespace fa2 {
typedef short bf16x8 __attribute__((ext_vector_type(8)));
typedef short s16x4 __attribute__((ext_vector_type(4)));
typedef float f32x16 __attribute__((ext_vector_type(16)));
typedef __attribute__((address_space(3))) const char* lds_cptr;
struct CfgMLA   { static constexpr int DQK = 96,  DV = 64,  QP = 768, KP = 768,  VP = 1024, OP = 1024, QHS = 96,  KHS = 96,  VHS = 128, OHS = 64;  static constexpr bool CAUSAL = true,  QNORM = true,  QROPE = true;  };
struct CfgCross { static constexpr int DQK = 128, DV = 128, QP = 512, KP = 1024, VP = 1024, OP = 512,  QHS = 128, KHS = 128, VHS = 128, OHS = 128; static constexpr bool CAUSAL = false, QNORM = true,  QROPE = false; };
struct TagT { static constexpr bool value = true; }; struct TagF { static constexpr bool value = false; };
__device__ __forceinline__ int crow(int r, int hi) { return (r & 3) + 8 * (r >> 2) + 4 * hi; }
__device__ __forceinline__ void glds16(const void* g, unsigned lds_dst) { unsigned sv;
    asm volatile("s_mov_b32 %0, m0\n\ts_mov_b32 m0, %2\n\ts_nop 0\n\tglobal_load_lds_dwordx4 %1, off\n\ts_mov_b32 m0, %0" : "=&s"(sv) : "v"(g), "s"(lds_dst) : "memory"); }
__device__ __forceinline__ s16x4 vtr(lds_cptr p) { typedef short v4i16_t __attribute__((ext_vector_type(4))); return __builtin_bit_cast(s16x4, __builtin_amdgcn_ds_read_tr16_b64_v4i16((__attribute__((address_space(3))) v4i16_t*)p)); }
__device__ __forceinline__ unsigned cvtpk(float lo, float hi) { typedef float f2 __attribute__((ext_vector_type(2))); typedef __bf16 b2 __attribute__((ext_vector_type(2))); f2 v = {lo, hi}; b2 b = __builtin_convertvector(v, b2); return __builtin_bit_cast(unsigned, b); }
#define MLA_WAIT_BAR() asm volatile("s_waitcnt vmcnt(0) lgkmcnt(0)\n\ts_barrier" ::: "memory")

template <class C, int THR> __device__ __forceinline__ void unit(long q_row0, long kv_row0, int h, int NT, const bf16_t* Q, const bf16_t* K, const bf16_t* V, bf16_t* O, LAS unsigned char* L, const float* qgain = nullptr, float qscale = 1.f, const float* rope = nullptr, bool pre_issued = false, bool issue_next = false) {
    constexpr int DQK = C::DQK, DV = C::DV, QP = C::QP, KP = C::KP, VP = C::VP, OP = C::OP, NKC = DQK / 8, NDB = DV / 32;
    constexpr int KSLOT = NKC * 1024, VSLOT = NDB * 4096, SLOT = KSLOT + VSLOT, NSLOT = 3, LDS_WS = NSLOT * SLOT, LDS_OST = 65536  ;
    static_assert(LDS_WS + 8 * 256 <= LDS_OST && LDS_OST + 8 * 32 * DV * 2 <= RING_BYTES, "fa lds");
    const int tid = tid_opaque(), lane = tid & 63, r32 = lane & 31, hi = lane >> 5; const int wid = __builtin_amdgcn_readfirstlane(tid >> 6);
    const bf16_t* Qw = Q + (q_row0 + wid * 32) * QP + h * C::QHS;
    const bf16_t* Kh = K + kv_row0 * KP + h * C::KHS; const bf16_t* Vh = V + kv_row0 * VP + h * C::VHS;
    const unsigned lds0 = (unsigned)(uintptr_t)L;
    LAS float* wsf = (LAS float*)(L + LDS_WS) + wid * 64;
    const bf16_t* ksrc0 = Kh + (long)lane * KP + wid * 8; const bf16_t* ksrc1 = ksrc0 + 64;
    const bf16_t* vsrc = Vh + (long)(16 * (wid & 3) + (lane >> 2)) * VP + (wid >> 2) * 32 + (lane & 3) * 8;
    const unsigned kdst0 = lds0 + wid * 1024, kdst1 = kdst0 + 8192, vdst = lds0 + KSLOT + wid * 1024;
#define MLA_DMA(t, slot) do { glds16(ksrc0 + (long)(t) * 64 * KP, (unsigned)__builtin_amdgcn_readfirstlane(kdst0 + (slot))); \
        if (8 + wid < NKC) glds16(ksrc1 + (long)(t) * 64 * KP, (unsigned)__builtin_amdgcn_readfirstlane(kdst1 + (slot))); \
        glds16(vsrc + (long)(t) * 64 * VP, (unsigned)__builtin_amdgcn_readfirstlane(vdst + (slot))); \
        if (NDB == 4) glds16(vsrc + (long)(t) * 64 * VP + 64, (unsigned)__builtin_amdgcn_readfirstlane(vdst + 8192 + (slot))); } while (0)
    const lds_cptr kp0 = (lds_cptr)L + hi * 1024 + r32 * 16;
    const lds_cptr vp0 = (lds_cptr)L + KSLOT + ((lane >> 4) & 1) * 32 + (lane & 3) * 8 + (4 * hi + ((lane & 15) >> 2)) * 64;
    if (!pre_issued) { MLA_DMA(0, 0); if (NT > 1) MLA_DMA(1, SLOT); }
    bf16x8 qr[DQK / 16];
#pragma unroll
    for (int d0 = 0; d0 < DQK / 16; ++d0) qr[d0] = *reinterpret_cast<const bf16x8*>(Qw + (long)r32 * QP + d0 * 16 + hi * 8);
    if constexpr (C::QNORM) {
        float sq = 0.f;
#pragma unroll
        for (int d0 = 0; d0 < DQK / 16; ++d0)
#pragma unroll
            for (int j = 0; j < 8; ++j) { const float x = __builtin_bit_cast(float, (unsigned)(unsigned short)qr[d0][j] << 16); sq += x * x; }
        { auto rr = __builtin_amdgcn_permlane32_swap(__float_as_uint(sq), __float_as_uint(sq), false, false); sq = __uint_as_float(rr[0]) + __uint_as_float(rr[1]); }
        const float rs = qscale * __builtin_amdgcn_rsqf(sq * (1.0f / DQK) + EPS);
        float xq[DQK / 16][8];
#pragma unroll
        for (int d0 = 0; d0 < DQK / 16; ++d0) { const f32x4 g0 = *(const f32x4*)(qgain + 16 * d0 + 8 * hi), g1 = *(const f32x4*)(qgain + 16 * d0 + 8 * hi + 4);
#pragma unroll
            for (int j = 0; j < 8; ++j) xq[d0][j] = __builtin_bit_cast(float, (unsigned)(unsigned short)qr[d0][j] << 16) * rs * (j < 4 ? g0[j] : g1[j - 4]); }
        if constexpr (C::QROPE) {
            const float* rt = rope + (q_row0 + wid * 32 + r32) * ROPE_W + 8 * hi;
            const f32x4 c0 = *(const f32x4*)rt, c1 = *(const f32x4*)(rt + 4), s0 = *(const f32x4*)(rt + 16), s1 = *(const f32x4*)(rt + 20);
#pragma unroll
            for (int j = 0; j < 8; ++j) { const float c = j < 4 ? c0[j] : c1[j - 4], sn = j < 4 ? s0[j] : s1[j - 4]; const float a = xq[4][j], b = xq[5][j]; xq[4][j] = a * c - b * sn; xq[5][j] = b * c + a * sn; }
        }
#pragma unroll
        for (int d0 = 0; d0 < DQK / 16; ++d0) { typedef unsigned u4 __attribute__((ext_vector_type(4)));
            u4 w; w.x = cvtpk(xq[d0][0], xq[d0][1]); w.y = cvtpk(xq[d0][2], xq[d0][3]); w.z = cvtpk(xq[d0][4], xq[d0][5]); w.w = cvtpk(xq[d0][6], xq[d0][7]); qr[d0] = __builtin_bit_cast(bf16x8, w); }
    }
    const bf16x8 kone = (bf16x8){(short)(hi == 0 ? 0x3F80 : 0), 0, 0, 0, 0, 0, 0, 0}; bf16x8 qx = (bf16x8){0, 0, 0, 0, 0, 0, 0, 0};
    float mrow = 0.f, l0 = 0.f, l1 = 0.f, l2 = 0.f, l3 = 0.f; f32x16 o[NDB];
#pragma unroll
    for (int d0 = 0; d0 < NDB; ++d0) o[d0] = f32x16{};
    const int qrel = wid * 32 + r32;
    const int ndma = 1 + ((8 + wid < NKC) ? 1 : 0) + (NDB == 4 ? 2 : 1);
#define MLA_WAIT_KEEP(cond_keep) do { if (cond_keep) { if (ndma == 2) asm volatile("s_waitcnt vmcnt(2) lgkmcnt(0)\n\ts_barrier" ::: "memory"); else if (ndma == 3) asm volatile("s_waitcnt vmcnt(3) lgkmcnt(0)\n\ts_barrier" ::: "memory"); else asm volatile("s_waitcnt vmcnt(4) lgkmcnt(0)\n\ts_barrier" ::: "memory"); } else MLA_WAIT_BAR(); } while (0)
    MLA_WAIT_BAR();
#define FA_BLOCK_A(HN) do { bf16x8 kfr[KD]; if (HN) { _Pragma("unroll") for (int g_ = 0; g_ < KD; ++g_) kfr[g_] = FA_KLD((g_ >> 1) * 2048 + (g_ & 1) * 512); } _Pragma("unroll") for (int gg = 0; gg < NG + 2; ++gg) { if (HN) { if (gg == 0) pn0 = __builtin_amdgcn_mfma_f32_32x32x16_bf16(kone, qx, f32x16{}, 0, 0, 0); else if (gg == 1) pn1 = __builtin_amdgcn_mfma_f32_32x32x16_bf16(kone, qx, f32x16{}, 0, 0, 0); else { const int g = gg - 2, d0 = g >> 1; const bf16x8 kf = kfr[g % KD]; if (g + KD < NG) kfr[g % KD] = FA_KLD(((g + KD) >> 1) * 2048 + ((g + KD) & 1) * 512); if (g & 1) pn1 = __builtin_amdgcn_mfma_f32_32x32x16_bf16(kf, qr[d0], pn1, 0, 0, 0); else pn0 = __builtin_amdgcn_mfma_f32_32x32x16_bf16(kf, qr[d0], pn0, 0, 0, 0); } } if (gg < 8) { _Pragma("unroll") for (int e = 0; e < 4; ++e) { const int r = (4 * gg + e) & 15; if (gg < 4) pc0[r] = __builtin_amdgcn_exp2f(pc0[r]); else pc1[r] = __builtin_amdgcn_exp2f(pc1[r]); } if (gg < 4) FA_PIN(pc0); else FA_PIN(pc1); } else if (gg < 12) { const int ks = gg - 8, bb = (ks & 1) * 8; const f32x16& P = (ks < 2) ? pc0 : pc1; FA_ADD(l0, P[bb + 0]); FA_ADD(l1, P[bb + 1]); FA_ADD(l2, P[bb + 2]); FA_ADD(l3, P[bb + 3]); FA_ADD(l0, P[bb + 4]); FA_ADD(l1, P[bb + 5]); FA_ADD(l2, P[bb + 6]); FA_ADD(l3, P[bb + 7]); typedef unsigned u4 __attribute__((ext_vector_type(4))); u4 w; w.x = cvtpk(P[bb + 0], P[bb + 1]); w.y = cvtpk(P[bb + 2], P[bb + 3]); w.z = cvtpk(P[bb + 4], P[bb + 5]); w.w = cvtpk(P[bb + 6], P[bb + 7]); pa[ks] = __builtin_bit_cast(bf16x8, w); FA_PIN(pa[ks]); } FA_SB(); } } while (0)
#define FA_PIN(x) asm volatile("" : "+v"(x))
#define FA_ADD(acc, x) asm("v_add_f32 %0, %0, %1" : "+v"(acc) : "v"(x))
#define FA_SB() __builtin_amdgcn_sched_barrier(0)
#define FA_KLD(off) (*(const __attribute__((address_space(3))) bf16x8*)(kpn + (off)))
#define FA_MASK(P0, P1, tt) do { const int jb_ = (tt) - (NT - 4); if (C::CAUSAL && jb_ >= 0) { const int kb_ = 64 * jb_ + 4 * hi; \
        _Pragma("unroll") for (int r = 0; r < 16; ++r) { const int kv = kb_ + (r & 3) + 8 * (r >> 2); if (kv > qrel) P0[r] = -INFINITY; if (kv + 32 > qrel) P1[r] = -INFINITY; } } } while (0)
#define FA_BF16R(x) __builtin_bit_cast(float, f2bf(x) << 16)
#define FA_SETQX() do { const short nb_ = (short)f2bf(-mrow); qx = (bf16x8){(short)(hi == 0 ? nb_ : (short)0), 0, 0, 0, 0, 0, 0, 0}; } while (0)
#define FA_DECIDE(RM, P0, P1) do { float rm_ = (RM); { auto rr = __builtin_amdgcn_permlane32_swap(__float_as_uint(rm_), __float_as_uint(rm_), false, false); rm_ = fmaxf(__uint_as_float(rr[0]), __uint_as_float(rr[1])); } \
        if (__any(rm_ > (float)THR)) { const float mnew = FA_BF16R(mrow + fmaxf(rm_, 0.f)); const float delta = mnew - mrow; const float alpha = __builtin_amdgcn_exp2f(-delta); mrow = mnew; FA_SETQX(); l0 *= alpha; l1 *= alpha; l2 *= alpha; l3 *= alpha; \
            _Pragma("unroll") for (int r = 0; r < 16; ++r) { P0[r] -= delta; P1[r] -= delta; } \
            if (hi == 0) wsf[r32] = alpha; asm volatile("s_waitcnt lgkmcnt(0)" ::: "memory"); \
            _Pragma("unroll") for (int r = 0; r < 16; ++r) { const float f = wsf[crow(r, hi)]; _Pragma("unroll") for (int d0 = 0; d0 < NDB; ++d0) o[d0][r] *= f; } } } while (0)
    constexpr int NG = DQK / 8, NPV = NDB * 4, KD = 4, VD = 3;
    int slot = 0, slot2 = 2 * SLOT;
    f32x16 sa0, sa1, sb0, sb1;
    { const lds_cptr kpn = kp0;
      sa0 = f32x16{}; sa1 = f32x16{};
#pragma unroll
      for (int d0 = 0; d0 < DQK / 16; ++d0) { sa0 = __builtin_amdgcn_mfma_f32_32x32x16_bf16(FA_KLD(d0 * 2048), qr[d0], sa0, 0, 0, 0); sa1 = __builtin_amdgcn_mfma_f32_32x32x16_bf16(FA_KLD(d0 * 2048 + 512), qr[d0], sa1, 0, 0, 0); }
      FA_MASK(sa0, sa1, 0);
      float rma = fmaxf(sa0[0], sa1[0]);
#pragma unroll
      for (int r = 1; r < 16; ++r) rma = fmaxf(rma, fmaxf(sa0[r], sa1[r]));
      { auto rr = __builtin_amdgcn_permlane32_swap(__float_as_uint(rma), __float_as_uint(rma), false, false); rma = fmaxf(__uint_as_float(rr[0]), __uint_as_float(rr[1])); }
      mrow = FA_BF16R(rma); FA_SETQX();
#pragma unroll
      for (int r = 0; r < 16; ++r) { sa0[r] -= mrow; sa1[r] -= mrow; } }
    auto step = [&](auto hn, f32x16& pc0, f32x16& pc1, f32x16& pn0, f32x16& pn1, const int t) __attribute__((always_inline)) {
        constexpr bool HN = decltype(hn)::value;
        if (t + 2 < NT) MLA_DMA(t + 2, slot2);
        const lds_cptr kpn = kp0 + ((slot == 2 * SLOT) ? 0 : slot + SLOT);
        bf16x8 pa[4];
        FA_SB();
        FA_BLOCK_A(HN);
        if (HN) FA_MASK(pn0, pn1, t + 1);
        const lds_cptr vp = vp0 + slot;
        float rma = -INFINITY, rmb = -INFINITY;
        FA_SB();
        s16x4 vlo[VD], vhh[VD];
#pragma unroll
        for (int i = 0; i < VD; ++i) { vlo[i] = vtr(vp + (i >> 2) * 4096 + (i & 3) * 1024); vhh[i] = vtr(vp + (i >> 2) * 4096 + (i & 3) * 1024 + 512); }
#pragma unroll
        for (int i = 0; i < NPV; ++i) { const int d0 = i >> 2, ks = i & 3;
            const bf16x8 vf = (bf16x8){vlo[i % VD][0], vlo[i % VD][1], vlo[i % VD][2], vlo[i % VD][3], vhh[i % VD][0], vhh[i % VD][1], vhh[i % VD][2], vhh[i % VD][3]};
            if (i + VD < NPV) { const int d1 = (i + VD) >> 2, k1 = (i + VD) & 3; vlo[i % VD] = vtr(vp + d1 * 4096 + k1 * 1024); vhh[i % VD] = vtr(vp + d1 * 4096 + k1 * 1024 + 512); }
            o[d0] = __builtin_amdgcn_mfma_f32_32x32x16_bf16(pa[ks], vf, o[d0], 0, 0, 0);
            if (HN && i < 8) { rma = fmaxf(rma, fmaxf(pn0[2 * i], pn1[2 * i])); rmb = fmaxf(rmb, fmaxf(pn0[2 * i + 1], pn1[2 * i + 1])); FA_PIN(rma); FA_PIN(rmb); }
            FA_SB();
        }
        if (HN) FA_DECIDE(fmaxf(rma, rmb), pn0, pn1);
        MLA_WAIT_BAR();
        slot2 = slot; slot = (slot == 2 * SLOT) ? 0 : slot + SLOT;
    };
    const bool skip2 = C::CAUSAL && wid < 4; const int NTw = skip2 ? NT - 2 : NT;
    for (int t = 0; t < NTw; t += 2) {
        step(TagT{}, sa0, sa1, sb0, sb1, t);
        if (t + 2 < NTw) step(TagT{}, sb0, sb1, sa0, sa1, t + 1); else step(TagF{}, sb0, sb1, sa0, sa1, t + 1);
    }
    if (skip2) { MLA_WAIT_BAR(); MLA_WAIT_BAR(); }
    if (issue_next) { MLA_DMA(0, 0); MLA_DMA(1, SLOT); }
    const float lsum_ = (l0 + l1) + (l2 + l3);
#undef FA_ADD
#undef FA_PIN
#undef FA_BLOCK_A
#undef FA_SB
#undef FA_KLD
#undef FA_MASK
#undef FA_DECIDE
#undef FA_BF16R
#undef FA_SETQX
    float lsum = lsum_;
    { auto rr = __builtin_amdgcn_permlane32_swap(__float_as_uint(lsum), __float_as_uint(lsum), false, false); lsum = __uint_as_float(rr[0]) + __uint_as_float(rr[1]); }
    if (hi == 0) wsf[32 + r32] = lsum;
    asm volatile("s_waitcnt lgkmcnt(0)" ::: "memory");
    float rli[16];
#pragma unroll
    for (int r = 0; r < 16; ++r) rli[r] = __builtin_amdgcn_rcpf(wsf[32 + crow(r, hi)]);
    bf16_t* Ow = O + (q_row0 + wid * 32) * OP + h * C::OHS;
    { LAS bf16_t* stg = (LAS bf16_t*)(L + LDS_OST) + wid * (32 * DV);
#pragma unroll
      for (int r = 0; r < 16; ++r) { const int orow = crow(r, hi);
#pragma unroll
          for (int d0 = 0; d0 < NDB; ++d0) stg[orow * DV + d0 * 32 + r32] = (bf16_t)f2bf(o[d0][r] * rli[r]); }
      asm volatile("s_waitcnt lgkmcnt(0)" ::: "memory");
      constexpr int CPR = DV / 8;
#pragma unroll
      for (int i = 0; i < 32 * CPR / 64; ++i) { const int row = i * (64 / CPR) + lane / CPR, ch = lane % CPR; const u32x4 v = *(const LAS u32x4*)(stg + row * DV + ch * 8); *(u32x4*)(Ow + (long)row * OP + ch * 8) = v; } }
    asm volatile("s_waitcnt lgkmcnt(0)\n\ts_barrier" ::: "memory");
#undef MLA_DMA
#undef MLA_WAIT_KEEP
}
template <int THR> __device__ __forceinline__ void mla_phase(const bf16_t* Q, const bf16_t* K, const bf16_t* V, bf16_t* O, const float* qgain, const float* rope, LAS unsigned char* L, int G, int bid) {
    if (G == 256) {
        const int vcu = (bid % 8) * (G / 8) + bid / 8, s = vcu & 7, bh = vcu >> 3;
        for (int i = 0; i < 4; ++i) { const int qb = (i == 0) ? s : (i == 1) ? 15 - s : (i == 2) ? 16 + s : 31 - s; const long rb = (long)(bh / 8) * SEQ;
            unit<CfgMLA, THR>(rb + qb * 256, rb, bh % 8, 4 * qb + 4, Q, K, V, O, L, qgain, SC_MLA, rope, i > 0, i < 3); }
    } else {
        for (int u = bid; u < BATCH * 8 * 32; u += G) { const long rb = (long)(u / 256) * SEQ; const int qb = u % 32; unit<CfgMLA, THR>(rb + qb * 256, rb, (u / 32) % 8, 4 * qb + 4, Q, K, V, O, L, qgain, SC_MLA, rope); }
    }
}
template <int THR> __device__ __forceinline__ void cross_phase(const bf16_t* Q, const bf16_t* K, const bf16_t* V, bf16_t* O, const float* qgain, LAS unsigned char* L, int G, int bid) {
    for (int u = bid; u < BATCH * 4 * 32; u += G) { const int b = u / 128, h = (u / 32) % 4, qb = u % 32;
        unit<CfgCross, THR>((long)b * SEQ + qb * 256, (long)b * NMEM, h, NMEM / 64, Q, K, V, O, L, qgain, SC_MEM); }
}
}


namespace idx {
typedef short bf16x8 __attribute__((ext_vector_type(8)));
typedef float f32x16 __attribute__((ext_vector_type(16)));
typedef __attribute__((address_space(3))) const char* lds_cptr;
constexpr int STG = 8192;
constexpr int LDS_HIST = 3 * STG;
constexpr size_t SCR_WAVE_U32 = 8 * 4096;
__device__ __forceinline__ void glds16(const void* g, unsigned lds_dst) { unsigned sv;
    asm volatile("s_mov_b32 %0, m0\n\ts_mov_b32 m0, %2\n\ts_nop 0\n\tglobal_load_lds_dwordx4 %1, off\n\ts_mov_b32 m0, %0" : "=&s"(sv) : "v"(g), "s"(lds_dst) : "memory"); }
#define IDX_WAIT_BAR() asm volatile("s_waitcnt vmcnt(0) lgkmcnt(0)\n\ts_barrier" ::: "memory")
__device__ __forceinline__ unsigned keypair(float a, float b) {
    const auto h = __builtin_amdgcn_cvt_pkrtz(a, b); const unsigned w = __builtin_bit_cast(unsigned, h);
    const unsigned s = (w >> 15) & 0x00010001u; return w ^ ((s * 0xFFFFu) | 0x80008000u);
}
constexpr int NCOPY = 8, CSTR = 328;
__device__ __forceinline__ unsigned wave_prefix_incl(unsigned v) {
    v += (unsigned)__builtin_amdgcn_update_dpp(0, (int)v, 0x111, 0xF, 0xF, true);
    v += (unsigned)__builtin_amdgcn_update_dpp(0, (int)v, 0x112, 0xF, 0xF, true);
    v += (unsigned)__builtin_amdgcn_update_dpp(0, (int)v, 0x114, 0xF, 0xF, true);
    v += (unsigned)__builtin_amdgcn_update_dpp(0, (int)v, 0x118, 0xF, 0xF, true);
    v += (unsigned)__builtin_amdgcn_update_dpp(0, (int)v, 0x142, 0xA, 0xF, false);
    v += (unsigned)__builtin_amdgcn_update_dpp(0, (int)v, 0x143, 0xC, 0xF, false);
    return v;
}
__device__ __forceinline__ void find_bin(LAS unsigned* hist, unsigned target, int lane, unsigned& bin, unsigned& above_out) {
    u32x4 c = *(LAS u32x4*)(hist + 4 * lane);
#pragma unroll
    for (int k = 1; k < NCOPY; ++k) { const u32x4 d = *(LAS u32x4*)(hist + CSTR * k + 4 * lane); c.x += d.x; c.y += d.y; c.z += d.z; c.w += d.w; }
    const unsigned s = c.x + c.y + c.z + c.w;
    const unsigned pre = wave_prefix_incl(s), total = (unsigned)__builtin_amdgcn_readlane((int)pre, 63), suf = total - pre + s;
    const unsigned long long mk = __ballot(suf >= target);
    const int src = 63 - __builtin_clzll(mk);
    const unsigned above = (unsigned)__builtin_amdgcn_readlane((int)(suf - s), src);
    unsigned cum = above, bsel, ab;
    if (cum + c.w >= target) { bsel = 3; ab = cum; } else { cum += c.w;
        if (cum + c.z >= target) { bsel = 2; ab = cum; } else { cum += c.z;
            if (cum + c.y >= target) { bsel = 1; ab = cum; } else { cum += c.y; bsel = 0; ab = cum; } } }
    bin = (unsigned)__builtin_amdgcn_readlane((int)(4 * lane + bsel), src); above_out = (unsigned)__builtin_amdgcn_readlane((int)ab, src);
}
__device__ __forceinline__ unsigned mbcnt64(unsigned long long m) { return __builtin_amdgcn_mbcnt_hi((unsigned)(m >> 32), __builtin_amdgcn_mbcnt_lo((unsigned)m, 0u)); }
template <int NW> __device__ __forceinline__ void load_row(unsigned (&wr)[NW], const unsigned* srow, int nw32, int lane) {
    { const __amdgpu_buffer_rsrc_t rs = __builtin_amdgcn_make_buffer_rsrc((void*)srow, (short)0, nw32 * 4, 0x00020000);
      int off = lane * 4; asm volatile("" : "+v"(off));
#pragma unroll
      for (int v = 0; v < NW; ++v) wr[v] = __builtin_amdgcn_raw_buffer_load_b32(rs, off, 256 * v, 0); }
}
template <int NW> __device__ __forceinline__ void process_row(const unsigned (&wr)[NW], unsigned short* gout, LAS unsigned* hist, LAS unsigned short* out, int lane) {
    LAS unsigned* hc = hist + CSTR * (lane & (NCOPY - 1));
    LAS unsigned* dmy = hist + 256 + lane;
#pragma unroll
    for (int k = 0; k < NCOPY; ++k) *(LAS u32x4*)(hist + CSTR * k + 4 * lane) = (u32x4){0u, 0u, 0u, 0u};
    asm volatile("s_waitcnt lgkmcnt(0)" ::: "memory");
    { unsigned s8 = 8u, s24 = 24u; asm volatile("" : "+s"(s8), "+s"(s24));
#pragma unroll
      for (int v = 0; v < NW; ++v) { const unsigned w = wr[v];
        __hip_atomic_fetch_add(hc + ((w >> s8) & 0xFFu), 1u, __ATOMIC_RELAXED, __HIP_MEMORY_SCOPE_WORKGROUP);
        __hip_atomic_fetch_add(hc + (w >> s24), 1u, __ATOMIC_RELAXED, __HIP_MEMORY_SCOPE_WORKGROUP); if ((v & 3) == 3) __builtin_amdgcn_sched_barrier(0); } }
    asm volatile("s_waitcnt lgkmcnt(0)" ::: "memory");
    unsigned b1, above1; find_bin(hist, 256u, lane, b1, above1);
    asm volatile("s_waitcnt lgkmcnt(0)" ::: "memory");
#pragma unroll
    for (int k = 0; k < NCOPY; ++k) *(LAS u32x4*)(hist + CSTR * k + 4 * lane) = (u32x4){0u, 0u, 0u, 0u};
    asm volatile("s_waitcnt lgkmcnt(0)" ::: "memory");
#pragma unroll
    for (int v = 0; v < NW; ++v) { const unsigned w = wr[v];
        LAS unsigned* a0 = (((w >> 8) & 0xFFu) == b1) ? hc + (w & 0xFFu) : dmy; LAS unsigned* a1 = ((w >> 24) == b1) ? hc + ((w >> 16) & 0xFFu) : dmy;
        __hip_atomic_fetch_add(a0, 1u, __ATOMIC_RELAXED, __HIP_MEMORY_SCOPE_WORKGROUP);
        __hip_atomic_fetch_add(a1, 1u, __ATOMIC_RELAXED, __HIP_MEMORY_SCOPE_WORKGROUP); if ((v & 3) == 3) __builtin_amdgcn_sched_barrier(0); }
    asm volatile("s_waitcnt lgkmcnt(0)" ::: "memory");
    unsigned b2, above2; find_bin(hist, 256u - above1, lane, b2, above2);
    const unsigned T = (b1 << 8) | b2, T1 = T - 1u, gt_total = above1 + above2;
    unsigned mg[NW / 16], mq[NW / 16];
#pragma unroll
    for (int gi = 0; gi < NW / 16; ++gi) { unsigned a = 0u, e = 0u;
#pragma unroll
        for (int vv = 0; vv < 16; ++vv) { const unsigned w = wr[16 * gi + vv]; const unsigned klo = w & 0xFFFFu, khi = w >> 16;
            a = __builtin_amdgcn_alignbit(a, T - klo, 31); e = __builtin_amdgcn_alignbit(e, T1 - klo, 31);
            a = __builtin_amdgcn_alignbit(a, T - khi, 31); e = __builtin_amdgcn_alignbit(e, T1 - khi, 31); }
        mg[gi] = a; mq[gi] = e & ~a; }
    unsigned base_gt = 0u;
#pragma unroll
    for (int gi = 0; gi < NW / 16; ++gi) { unsigned m = mg[gi];
        for (;;) { const unsigned long long act = __ballot(m != 0u); if (!act) break;
            if (m != 0u) { const int bpos = 31 - __builtin_clz(m), j = 31 - bpos; m &= ~(1u << bpos);
                out[base_gt + mbcnt64(act)] = (unsigned short)(2 * (64 * (16 * gi + (j >> 1)) + lane) + (j & 1)); }
            base_gt += (unsigned)__popcll(act); } }
    unsigned base_eq = gt_total;
#pragma unroll
    for (int gi = 0; gi < NW / 16; ++gi) { unsigned m = mq[gi];
        for (;;) { if (base_eq >= 256u) break; const unsigned long long act = __ballot(m != 0u); if (!act) break;
            if (m != 0u) { const int bpos = 31 - __builtin_clz(m), j = 31 - bpos; m &= ~(1u << bpos); const unsigned e = base_eq + mbcnt64(act);
                if (e < 256u) out[e] = (unsigned short)(2 * (64 * (16 * gi + (j >> 1)) + lane) + (j & 1)); }
            base_eq += (unsigned)__popcll(act); } }
    asm volatile("s_waitcnt lgkmcnt(0)" ::: "memory");
    *(u32x2*)(gout + 4 * lane) = *(LAS u32x2*)(out + 4 * lane);
}
template <int NW> __device__ __forceinline__ void select8(const unsigned* scr, int nw32, unsigned short* sel0, LAS unsigned* hist, LAS unsigned short* sbuf, int lane) {
    unsigned wa[NW], wb[NW];
    load_row<NW>(wa, scr, nw32, lane);
#pragma unroll 1
    for (int i = 0; i < 8; i += 2) {
        load_row<NW>(wb, scr + (size_t)(i + 1) * 4096, nw32, lane);
        process_row<NW>(wa, sel0 + (size_t)i * 256, hist, sbuf, lane);
        if (i + 2 < 8) load_row<NW>(wa, scr + (size_t)(i + 2) * 4096, nw32, lane);
        process_row<NW>(wb, sel0 + (size_t)(i + 1) * 256, hist, sbuf, lane);
    }
}
__device__ __forceinline__ void unit(int b, int ub, const bf16_t* proj, const bf16_t* Ki, const float* Wi, unsigned short* SEL, unsigned* scr, LAS unsigned char* L) {
    const int tid = tid_opaque(), lane = tid & 63, n32 = lane & 31, hb = lane >> 5; const int wid = __builtin_amdgcn_readfirstlane(tid >> 6);
    const long rowb = (long)b * SEQ; const int t0w = 64 * ub + 8 * wid;
    const int hbm = (n32 >> 2) & 1, rr = (n32 & 3) + 4 * (n32 >> 3), qq = 2 * hbm + (rr >> 3), hh = rr & 7;
    bf16x8 af[2][4];
#pragma unroll
    for (int ta = 0; ta < 2; ++ta) { const bf16_t* qp = proj + (rowb + t0w + 4 * ta + qq) * PP + C_QI + hh * 64 + hb * 8;
#pragma unroll
        for (int kk = 0; kk < 4; ++kk) af[ta][kk] = *reinterpret_cast<const bf16x8*>(qp + 16 * kk); }
    f32x4 wq[2][2][2];
#pragma unroll
    for (int ta = 0; ta < 2; ++ta)
#pragma unroll
        for (int j = 0; j < 2; ++j) { const float* wp = Wi + (rowb + t0w + 4 * ta + 2 * hb + j) * 8; wq[ta][j][0] = *(const f32x4*)wp; wq[ta][j][1] = *(const f32x4*)(wp + 4); }
    const unsigned lds0 = (unsigned)(uintptr_t)L;
    const bf16_t* ksrc = Ki + (rowb + 2 * n32 + hb) * 64 + wid * 8;
    const unsigned kdst = lds0 + wid * 1024;
    const lds_cptr bp0 = (lds_cptr)L + hb * 1024 + n32 * 16;
    const int nst = ub + 1;
    unsigned* srow_w = scr + (size_t)(2 * hb) * 4096 + n32;
    glds16(ksrc, (unsigned)__builtin_amdgcn_readfirstlane(kdst));
    if (nst > 1) glds16(ksrc + (size_t)64 * 64, (unsigned)__builtin_amdgcn_readfirstlane(kdst + STG));
    if (nst > 1) asm volatile("s_waitcnt vmcnt(1) lgkmcnt(0)\n\ts_barrier" ::: "memory"); else IDX_WAIT_BAR();
#define IX_PIN(x) asm volatile("" : "+v"(x))
#define IX_SB() __builtin_amdgcn_sched_barrier(0)
#define IX_SLICE(SC, ACC, c, hq) do { const int ta_ = (c) >> 1, j_ = (c) & 1; float t0_, t1_, t2_, t3_; asm("v_max_f32 %1, 0, %5\n\tv_max_f32 %2, 0, %6\n\tv_fmac_f32 %0, %9, %1\n\tv_max_f32 %3, 0, %7\n\tv_fmac_f32 %0, %10, %2\n\tv_max_f32 %4, 0, %8\n\tv_fmac_f32 %0, %11, %3\n\tv_fmac_f32 %0, %12, %4" : "+v"(SC[c]), "=&v"(t0_), "=&v"(t1_), "=&v"(t2_), "=&v"(t3_) : "v"(ACC[ta_][8 * j_ + 4 * (hq) + 0]), "v"(ACC[ta_][8 * j_ + 4 * (hq) + 1]), "v"(ACC[ta_][8 * j_ + 4 * (hq) + 2]), "v"(ACC[ta_][8 * j_ + 4 * (hq) + 3]), "v"(wq[ta_][j_][hq][0]), "v"(wq[ta_][j_][hq][1]), "v"(wq[ta_][j_][hq][2]), "v"(wq[ta_][j_][hq][3])); IX_PIN(SC[c]); } while (0)
    unsigned res[4] = {0u, 0u, 0u, 0u};
    f32x16 accA[2], accB[2]; float scA[4] = {0.f, 0.f, 0.f, 0.f}, scB[4] = {0.f, 0.f, 0.f, 0.f};
    accB[0] = f32x16{}; accB[1] = f32x16{};
    int buf = 0, buf2 = 2 * STG;
    for (int st = 0; st < nst; ++st) {
        if (st + 2 < nst) glds16(ksrc + (size_t)(st + 2) * 64 * 64, (unsigned)__builtin_amdgcn_readfirstlane(kdst + buf2));
        bf16x8 bfr[4], bfs[4];
#pragma unroll
        for (int kk = 0; kk < 4; ++kk) bfr[kk] = *(const __attribute__((address_space(3))) bf16x8*)(bp0 + buf + kk * 2048);
#pragma unroll
        for (int kk = 0; kk < 4; ++kk) bfs[kk] = *(const __attribute__((address_space(3))) bf16x8*)(bp0 + buf + kk * 2048 + 512);
#pragma unroll
        for (int c = 0; c < 4; ++c) scB[c] = 0.f;
        IX_SB();
#pragma unroll
        for (int i = 0; i < 8; ++i) { const int ta = i >> 2, kk = i & 3;
            accA[ta] = __builtin_amdgcn_mfma_f32_32x32x16_bf16(af[ta][kk], bfr[kk], kk == 0 ? f32x16{} : accA[ta], 0, 0, 0);
            IX_SLICE(scB, accB, i >> 1, i & 1);
            IX_SB(); }
        if (st > 0) {
#pragma unroll
            for (int c = 0; c < 4; ++c) { res[c] = keypair(scA[c], scB[c]); srow_w[(size_t)(4 * (c >> 1) + (c & 1)) * 4096 + 32 * (st - 1)] = res[c]; }
        }
#pragma unroll
        for (int c = 0; c < 4; ++c) scA[c] = 0.f;
        IX_SB();
#pragma unroll
        for (int i = 0; i < 8; ++i) { const int ta = i >> 2, kk = i & 3;
            accB[ta] = __builtin_amdgcn_mfma_f32_32x32x16_bf16(af[ta][kk], bfs[kk], kk == 0 ? f32x16{} : accB[ta], 0, 0, 0);
            IX_SLICE(scA, accA, i >> 1, i & 1);
            IX_SB(); }
        { const bool ks = st > 0, kd = st + 2 < nst;
          if (st >= 2 && kd) asm volatile("s_waitcnt vmcnt(9) lgkmcnt(0)\n\ts_barrier" ::: "memory");
          else if (st >= 2) asm volatile("s_waitcnt vmcnt(8) lgkmcnt(0)\n\ts_barrier" ::: "memory");
          else if (ks) asm volatile("s_waitcnt vmcnt(4) lgkmcnt(0)\n\ts_barrier" ::: "memory");
          else IDX_WAIT_BAR(); }
        buf2 = buf; buf = (buf == 2 * STG) ? 0 : buf + STG;
    }
#pragma unroll
    for (int c = 0; c < 4; ++c) { scB[c] = 0.f; IX_SLICE(scB, accB, c, 0); IX_SLICE(scB, accB, c, 1); }
#pragma unroll
    for (int ta = 0; ta < 2; ++ta)
#pragma unroll
        for (int j = 0; j < 2; ++j) { unsigned rv = keypair(scA[ta * 2 + j], scB[ta * 2 + j]); const int t = t0w + 4 * ta + 2 * hb + j, k0 = 64 * (nst - 1) + 2 * n32;
            if (k0 > t) rv &= 0xFFFF0000u; if (k0 + 1 > t) rv &= 0x0000FFFFu;
            srow_w[(size_t)(4 * ta + j) * 4096 + 32 * (nst - 1)] = rv; }
#undef IX_PIN
#undef IX_SB
#undef IX_SLICE
    asm volatile("s_waitcnt vmcnt(0)" ::: "memory");
    LAS unsigned* hist = (LAS unsigned*)(L + LDS_HIST) + wid * (NCOPY * CSTR); LAS unsigned short* sbufw = (LAS unsigned short*)(L + LDS_HIST + 8 * NCOPY * CSTR * 4) + wid * 256;
    { unsigned short* sel0 = SEL + (size_t)(rowb + t0w) * 256;
      if (t0w + 8 <= 256) {
#pragma unroll 1
          for (int i = 0; i < 8; ++i) { const int n = t0w + i + 1;
#pragma unroll
              for (int j = 0; j < 4; ++j) { const int k = lane + 64 * j; sel0[(size_t)i * 256 + k] = k < n ? (unsigned short)k : (unsigned short)0xFFFFu; } }
      } else if (t0w + 8 <= 2048) select8<16>(scr, 32 * nst, sel0, hist, sbufw, lane);
      else if (t0w + 8 <= 4096) select8<32>(scr, 32 * nst, sel0, hist, sbufw, lane);
      else if (t0w + 8 <= 6144) select8<48>(scr, 32 * nst, sel0, hist, sbufw, lane);
      else select8<64>(scr, 32 * nst, sel0, hist, sbufw, lane); }
}
__device__ __forceinline__ void phase(const bf16_t* proj, const bf16_t* Ki, const float* Wi, unsigned short* SEL, unsigned* scrA, unsigned* scrB, LAS unsigned char* L, int G, int bid, int wave) {
    const int gwv = bid * 8 + wave;
    unsigned* scr = (gwv < 1024 ? scrA + (size_t)gwv * SCR_WAVE_U32 : scrB + (size_t)(gwv - 1024) * SCR_WAVE_U32);
    if (G == 256) {
        const int b = (bid & 7) >> 1, j = (bid >> 3) * 2 + (bid & 1);
        unit(b, 127 - j, proj, Ki, Wi, SEL, scr, L);
        unit(b, j, proj, Ki, Wi, SEL, scr, L);
    } else {
        for (int u = bid; u < BATCH * 128; u += G) unit(u >> 7, u & 127, proj, Ki, Wi, SEL, scr, L);
    }
    asm volatile("s_waitcnt vmcnt(0) lgkmcnt(0)\n\ts_barrier" ::: "memory");
}
}


namespace sparse {
typedef short bf16x8 __attribute__((ext_vector_type(8)));
typedef short s16x4 __attribute__((ext_vector_type(4)));
typedef __attribute__((address_space(3))) const char* lds_cptr;
__device__ __forceinline__ void glds16(const void* g, unsigned lds_dst) { unsigned sv;
    asm volatile("s_mov_b32 %0, m0\n\ts_mov_b32 m0, %2\n\ts_nop 0\n\tglobal_load_lds_dwordx4 %1, off\n\ts_mov_b32 m0, %0" : "=&s"(sv) : "v"(g), "s"(lds_dst) : "memory"); }
__device__ __forceinline__ void glds16_so(const void* sbase, unsigned voff, unsigned lds_dst) { unsigned sv;
    asm volatile("s_mov_b32 %0, m0\n\ts_mov_b32 m0, %3\n\ts_nop 0\n\tglobal_load_lds_dwordx4 %1, %2\n\ts_mov_b32 m0, %0" : "=&s"(sv) : "v"(voff), "s"(sbase), "s"(lds_dst) : "memory"); }
__device__ __forceinline__ float xmax16(float v) { auto r = __builtin_amdgcn_permlane16_swap(__float_as_uint(v), __float_as_uint(v), false, false); return fmaxf(__uint_as_float(r[0]), __uint_as_float(r[1])); }
__device__ __forceinline__ float xmax32(float v) { auto r = __builtin_amdgcn_permlane32_swap(__float_as_uint(v), __float_as_uint(v), false, false); return fmaxf(__uint_as_float(r[0]), __uint_as_float(r[1])); }
__device__ __forceinline__ float xsum16(float v) { auto r = __builtin_amdgcn_permlane16_swap(__float_as_uint(v), __float_as_uint(v), false, false); return __uint_as_float(r[0]) + __uint_as_float(r[1]); }
__device__ __forceinline__ float xsum32(float v) { auto r = __builtin_amdgcn_permlane32_swap(__float_as_uint(v), __float_as_uint(v), false, false); return __uint_as_float(r[0]) + __uint_as_float(r[1]); }
__device__ __forceinline__ s16x4 vtr(lds_cptr p) { typedef short v4i16_t __attribute__((ext_vector_type(4))); return __builtin_bit_cast(s16x4, __builtin_amdgcn_ds_read_tr16_b64_v4i16((__attribute__((address_space(3))) v4i16_t*)p)); }
__device__ __forceinline__ unsigned cvtpk(float lo, float hi) { typedef float f2 __attribute__((ext_vector_type(2))); typedef __bf16 b2 __attribute__((ext_vector_type(2))); f2 v = {lo, hi}; b2 b = __builtin_convertvector(v, b2); return __builtin_bit_cast(unsigned, b); }

__device__ __forceinline__ void query(int row, const bf16_t* proj, const bf16_t* kvd, const unsigned short* SEL, bf16_t* mix, LAS unsigned char* Lw, int lane) {
    const int b = row / SEQ, t = row % SEQ, n16 = lane & 15, kq = lane >> 4, h32 = lane >> 5, pos = lane & 31;
    const int nvalid = (t + 1) < 256 ? (t + 1) : 256;
    const unsigned lds0 = (unsigned)(uintptr_t)Lw;
    bf16x8 qf[2][2];
#pragma unroll
    for (int g = 0; g < 2; ++g)
#pragma unroll
        for (int ks = 0; ks < 2; ++ks) { qf[g][ks] = (bf16x8){0, 0, 0, 0, 0, 0, 0, 0};
            if (n16 < 4) qf[g][ks] = *reinterpret_cast<const bf16x8*>(proj + (size_t)row * PP + C_QD + (4 * g + n16) * 64 + 32 * ks + 8 * kq); }
    const unsigned short* selr = SEL + (size_t)row * 256;
    const bf16_t* kvb = kvd + (size_t)b * SEQ * 256;
    float mrun[2] = {-INFINITY, -INFINITY}, lsum[2] = {0.f, 0.f};
    f32x4 o[2][4];
#pragma unroll
    for (int g = 0; g < 2; ++g)
#pragma unroll
        for (int nt = 0; nt < 4; ++nt) o[g][nt] = (f32x4){0.f, 0.f, 0.f, 0.f};
    u32x4 ixr[8];
#pragma unroll
    for (int c = 0; c < 8; ++c) ixr[c] = *(const u32x4*)(selr + 32 * c + 8 * kq);
    const int nch = (nvalid + 31) >> 5;
    if (nvalid < 256) {
#pragma unroll
        for (int c = 0; c < 8; ++c) { unsigned w4[4] = {ixr[c].x, ixr[c].y, ixr[c].z, ixr[c].w};
#pragma unroll
            for (int e = 0; e < 4; ++e) { unsigned lo = w4[e] & 0xFFFFu, hi = w4[e] >> 16; if (lo > (unsigned)t) lo = 0u; if (hi > (unsigned)t) hi = 0u; w4[e] = lo | (hi << 16); }
            ixr[c] = (u32x4){w4[0], w4[1], w4[2], w4[3]}; }
    }
#pragma unroll
    for (int c = 0; c < 8; ++c) asm volatile("" : "+v"(ixr[c]));
#define SP_ISSUE(c_, voff_, ldso_, ISV_) do { const unsigned w_[4] = {ixr[c_].x, ixr[c_].y, ixr[c_].z, ixr[c_].w}; \
        _Pragma("unroll") for (int i = 0; i < 8; ++i) { unsigned idx = (i & 1) ? (w_[i >> 1] >> 16) : (w_[i >> 1] & 0xFFFFu); \
            const int r = 4 * i + kq; const int lp = (ISV_) ? (n16 ^ (2 * (r & 7))) : (n16 ^ (r & 15)); \
            glds16_so(kvb, idx * 512u + (unsigned)((voff_) + lp * 16), (unsigned)__builtin_amdgcn_readfirstlane(lds0 + (ldso_) + i * 1024)); } } while (0)
    SP_ISSUE(0, 0, 0, false); SP_ISSUE(0, 256, 8192, true);
    const lds_cptr base = (lds_cptr)Lw;
#pragma unroll
    for (int c = 0; c < 8; ++c) {
        if (c < nch) {
            const bool more = c + 1 < nch;
            asm volatile("s_waitcnt vmcnt(8)" ::: "memory");
            bf16x8 kf[2][2][2];
#pragma unroll
            for (int g = 0; g < 2; ++g)
#pragma unroll
                for (int mt = 0; mt < 2; ++mt)
#pragma unroll
                    for (int ks = 0; ks < 2; ++ks) { const int piece = (g * 8 + ks * 4 + kq) ^ n16;
                        kf[g][mt][ks] = *(const __attribute__((address_space(3))) bf16x8*)(base + (16 * mt + n16) * 256 + piece * 16); }
            asm volatile("s_waitcnt lgkmcnt(0)" ::: "memory");
            if (more) { if (c + 1 < 8) SP_ISSUE(c + 1 < 8 ? c + 1 : 7, 0, 0, false); }
            bf16x8 pa[2];
            f32x4 sacc[2][2]; float cm[2];
#pragma unroll
            for (int g = 0; g < 2; ++g) {
#pragma unroll
                for (int mt = 0; mt < 2; ++mt) { f32x4 a = (f32x4){0.f, 0.f, 0.f, 0.f};
#pragma unroll
                    for (int ks = 0; ks < 2; ++ks) a = __builtin_amdgcn_mfma_f32_16x16x32_bf16(kf[g][mt][ks], qf[g][ks], a, 0, 0, 0);
                    sacc[g][mt] = a; }
            }
#pragma unroll
            for (int g = 0; g < 2; ++g) {
                if (32 * c + 32 > nvalid) {
#pragma unroll
                    for (int mt = 0; mt < 2; ++mt)
#pragma unroll
                        for (int i = 0; i < 4; ++i) { const int kp = 8 * i + 4 * mt + kq; if (32 * c + kp >= nvalid) sacc[g][mt][i] = -INFINITY; }
                }
                cm[g] = fmaxf(fmaxf(fmaxf(sacc[g][0][0], sacc[g][0][1]), fmaxf(sacc[g][0][2], sacc[g][0][3])), fmaxf(fmaxf(sacc[g][1][0], sacc[g][1][1]), fmaxf(sacc[g][1][2], sacc[g][1][3])));
            }
            cm[0] = xmax16(cm[0]); cm[1] = xmax16(cm[1]); cm[0] = xmax32(cm[0]); cm[1] = xmax32(cm[1]);
            if (__any(cm[0] > mrun[0] + 8.0f || cm[1] > mrun[1] + 8.0f)) {
#pragma unroll
                for (int g = 0; g < 2; ++g) {
                    const float mnew = fmaxf(mrun[g], cm[g]);
                    const float alpha = __builtin_amdgcn_exp2f(mrun[g] - mnew);
                    mrun[g] = mnew; lsum[g] *= alpha;
#pragma unroll
                    for (int i = 0; i < 4; ++i) { const float f = __shfl(alpha, 4 * kq + i);
#pragma unroll
                        for (int nt = 0; nt < 4; ++nt) o[g][nt][i] *= f; }
                }
            }
#pragma unroll
            for (int g = 0; g < 2; ++g) {
                const float mref = mrun[g];
                float p0[4], p1[4], ps = 0.f;
#pragma unroll
                for (int i = 0; i < 4; ++i) { p0[i] = __builtin_amdgcn_exp2f(sacc[g][0][i] - mref); p1[i] = __builtin_amdgcn_exp2f(sacc[g][1][i] - mref); ps += p0[i] + p1[i]; }
                lsum[g] += ps;
                typedef unsigned u4 __attribute__((ext_vector_type(4)));
                u4 pw; pw.x = cvtpk(p0[0], p0[1]); pw.y = cvtpk(p0[2], p0[3]); pw.z = cvtpk(p1[0], p1[1]); pw.w = cvtpk(p1[2], p1[3]);
                pa[g] = __builtin_bit_cast(bf16x8, pw);
            }
            if (more) asm volatile("s_waitcnt vmcnt(8)" ::: "memory"); else asm volatile("s_waitcnt vmcnt(0)" ::: "memory");
            const int qp = n16 >> 2, pp = n16 & 3;
#pragma unroll
            for (int g = 0; g < 2; ++g)
#pragma unroll
                for (int nt = 0; nt < 4; ++nt) {
                    const int r0 = 4 * kq + qp, r1 = r0 + 16, cv = g * 8 + 2 * nt + (pp >> 1);
                    const s16x4 lo = vtr(base + 8192 + r0 * 256 + ((cv ^ (2 * (r0 & 7))) * 16) + (pp & 1) * 8);
                    const s16x4 hi = vtr(base + 8192 + r1 * 256 + ((cv ^ (2 * (r1 & 7))) * 16) + (pp & 1) * 8);
                    const bf16x8 vf = (bf16x8){lo[0], lo[1], lo[2], lo[3], hi[0], hi[1], hi[2], hi[3]};
                    o[g][nt] = __builtin_amdgcn_mfma_f32_16x16x32_bf16(pa[g], vf, o[g][nt], 0, 0, 0);
                }
            asm volatile("s_waitcnt lgkmcnt(0)" ::: "memory");
            if (more) { if (c + 1 < 8) SP_ISSUE(c + 1 < 8 ? c + 1 : 7, 256, 8192, true); }
        }
    }
#undef SP_ISSUE
#pragma unroll
    for (int g = 0; g < 2; ++g) {
        float l = lsum[g]; l = xsum16(l); l = xsum32(l);
        float il[4];
#pragma unroll
        for (int i = 0; i < 4; ++i) il[i] = 1.0f / __shfl(l, i);
        if (kq == 0) {
            bf16_t* op = mix + (size_t)row * 1024 + 512 + (4 * g) * 64 + n16;
#pragma unroll
            for (int i = 0; i < 4; ++i)
#pragma unroll
                for (int nt = 0; nt < 4; ++nt) op[i * 64 + 16 * nt] = (bf16_t)f2bf(o[g][nt][i] * il[i]);
        }
    }
}
__device__ __forceinline__ void phase(const bf16_t* proj, const bf16_t* kvd, const unsigned short* SEL, bf16_t* mix, LAS unsigned char* L, int G, int bid, int wave, int lane) {
    LAS unsigned char* Lw = L + wave * 16384;
    if (G == 256) {
        const int b = (bid & 7) >> 1, wb = ((bid >> 3) * 2 + (bid & 1)) * 8 + wave;
        for (int t = wb; t < SEQ; t += 512) query(b * SEQ + t, proj, kvd, SEL, mix, Lw, lane);
    } else {
        for (int row = bid * 8 + wave; row < M; row += G * 8) query(row, proj, kvd, SEL, mix, Lw, lane);
    }
}
}


__device__ __forceinline__ unsigned char* ws_at(unsigned char* ws, size_t off) { unsigned long long q = (unsigned long long)(ws + off); asm volatile("" : "+s"(q)); return AS_GLOBAL(unsigned char*, q); }
#define GEMM_PHASE(EpiT, Eobj, Aptr, lda_, Bptr, ldb_, M_, N_, K_) GEMM_PHASE_O(EpiT, Eobj, Aptr, lda_, Bptr, ldb_, M_, N_, K_, 0)
#define GEMM_PHASE_O(EpiT, Eobj, Aptr, lda_, Bptr, ldb_, M_, N_, K_, BOFF_) do { \
    int k_rt_ = (K_), lda_rt_ = (lda_), ldb_rt_ = (ldb_), m_rt_ = (M_), n_rt_ = (N_); \
    asm volatile("" : "+s"(k_rt_), "+s"(lda_rt_), "+s"(ldb_rt_), "+s"(m_rt_), "+s"(n_rt_));     \
    pg8::Gemm g_; g_.A = (Aptr); g_.Bt = (Bptr); g_.M = m_rt_; g_.N = n_rt_; g_.K = k_rt_; g_.lda = lda_rt_; g_.ldb = ldb_rt_; g_.pad = 0; \
    pg8::StaticOrder S_; S_.init(m_rt_, n_rt_, G, (bid + (BOFF_)) % G); \
    pg8::gemm_phase<EpiT, pg8::StaticOrder, true, true>(L, g_, S_, (Eobj)); } while (0)

__global__ void __launch_bounds__(NTHREADS, 2) mega_fwd(Params p) {
    extern __shared__ __attribute__((aligned(16))) unsigned char lds[];
    LAS unsigned char* L = (LAS unsigned char*)lds;
    volatile LAS unsigned* MISC = (volatile LAS unsigned*)(L + MISC_OFF);
    const int tid0 = threadIdx.x, wave = __builtin_amdgcn_readfirstlane(tid0 >> 6);
    const int G = gridDim.x, bid = blockIdx.x;
    const int gw = bid * NWAVES + wave, NGW = G * NWAVES;
    if (tid0 < 32) MISC[tid0] = 0u;
    __syncthreads();
    XcdBarrier bar = xcd_barrier_post((unsigned*)(P_WS + WS_CTL) + CW_BAR, MISC + 8);

#define WSB(off) ((bf16_t*)ws_at(P_WS, (off)))
    { const int tid = tid_opaque(), lane = tid & 63; (void)tid; (void)lane;
      ph_weights(L, gw, NGW, wave, lane, true);
    }
    { const int tid = tid_opaque(), lane = tid & 63; (void)tid; (void)lane;
      ph_rope(((const int*)P_IN(2)), ((float*)ws_at(P_WS, WS_ROPE)), bid * NTHREADS + tid, G * NTHREADS);
    }
    { const int tid = tid_opaque(), lane = tid & 63; (void)tid; (void)lane;
      ph_rmsnorm_rows(P_IN(0), P_IN(3), WSB(WS_XN), M, gw, NGW, lane);
    }
    { const int tid = tid_opaque(), lane = tid & 63; (void)tid; (void)lane;
      ph_rmsnorm_rows(P_IN(1), P_IN(16), WSB(WS_MEMN), BATCH * NMEM, gw, NGW, lane);
    }
    { const int tid = tid_opaque(); f32x4* z = (f32x4*)ws_at(P_WS, WS_SSQ1); for (int i = bid * NTHREADS + tid; i < 4 * M / 4; i += G * NTHREADS) z[i] = (f32x4){0.f, 0.f, 0.f, 0.f}; }
    xcd_barrier(bar);
    { EpiProj E; E.pad = 0; GEMM_PHASE(EpiProj, E, WSB(WS_XN), 1024, WSB(WS_WIN), 1024, M, PP, 1024); }
    { pg8::EpiStore E; E.O = WSB(WS_KVC); E.ldc = 1024; E.pad = 0; GEMM_PHASE_O(pg8::EpiStore, E, WSB(WS_MEMN), 1024, WSB(WS_WMKV), 1024, BATCH * NMEM, 1024, 1024, 128); }
    if (G == 256 && bid >= 144) {
        const int tid = tid_opaque(), lane = tid & 63;
        ph_weights(L, (bid - 144) * NWAVES + wave, 112 * NWAVES, wave, lane, false);
    } else if (G != 256) { const int tid = tid_opaque(), lane = tid & 63; ph_weights(L, gw, NGW, wave, lane, false); }
    xcd_barrier(bar);
    { const int tid = tid_opaque(), lane = tid & 63; (void)tid; (void)lane;
      ph_headnorm128(WSB(WS_KVC), BATCH * NMEM, 1024, 0, 4, P_IN(21), 1.0f, gw, NGW, lane);
    }
    idx::phase(WSB(WS_PROJ), WSB(WS_KI), ((float*)ws_at(P_WS, WS_WI)), ((unsigned short*)ws_at(P_WS, WS_SEL)), (unsigned*)ws_at(P_WS, WS_XN), (unsigned*)P_OUT, L, G, bid, wave);
    { pg8::EpiStoreRS E; E.O = WSB(WS_QM); E.ssq = (const float*)ws_at(P_WS, WS_SSQ_CQ); E.ldc = 768; E.inv_ncols = 1.0f / 256.0f; E.eps = EPS; E.pad = 0; GEMM_PHASE(pg8::EpiStoreRS, E, WSB(WS_PROJ) + C_CQ, PP, WSB(WS_WUQ), 256, M, 768, 256); }
    { EpiKV E; E.pad = 0; GEMM_PHASE(EpiKV, E, WSB(WS_PROJ) + C_CKV, PP, WSB(WS_WUKV), 128, M, 1024, 128); }
    xcd_barrier(bar);
    fa2::mla_phase<8>(WSB(WS_QM), WSB(WS_KM), WSB(WS_KVM) + 64, WSB(WS_MIX), P_IN(9), (const float*)ws_at(P_WS, WS_ROPE), L, G, bid);
    { const int tid = tid_opaque(), lane = tid & 63; (void)tid; (void)lane;
      sparse::phase(WSB(WS_PROJ), WSB(WS_KVD), (const unsigned short*)ws_at(P_WS, WS_SEL), WSB(WS_MIX), L, G, bid, wave, lane);
    }
    xcd_barrier(bar);
    { pg8::EpiResNorm E; E.base = P_IN(0); E.baseb = nullptr; E.xb = WSB(WS_XN); E.ssq = (float*)ws_at(P_WS, WS_SSQ1); E.ldc = 1024; E.pad = 0; GEMM_PHASE(pg8::EpiResNorm, E, WSB(WS_MIX), 1024, WSB(WS_WOUT), 1024, M, 1024, 1024); }
    if (G == 256) grp_barrier(bar); else xcd_barrier(bar);
    { pg8::EpiStoreRS E; E.O = WSB(WS_QC); E.ssq = (const float*)ws_at(P_WS, WS_SSQ1); E.ldc = 512; E.inv_ncols = 1.0f / 1024.0f; E.eps = EPS; E.pad = 0; GEMM_PHASE(pg8::EpiStoreRS, E, WSB(WS_XN), 1024, WSB(WS_WMQ), 1024, M, 512, 1024); }
    if (G == 256) grp_barrier(bar); else xcd_barrier(bar);
    fa::cross_phase<0>(WSB(WS_QC), WSB(WS_KVC), WSB(WS_KVC) + 512, WSB(WS_QC), P_IN(20), L, G, bid);
    if (G == 256) grp_barrier(bar); else xcd_barrier(bar);
    { pg8::EpiResNorm E; E.base = nullptr; E.baseb = WSB(WS_XN); E.xb = WSB(WS_XN); E.ssq = (float*)ws_at(P_WS, WS_SSQ2); E.ldc = 1024; E.pad = 0; GEMM_PHASE(pg8::EpiResNorm, E, WSB(WS_QC), 512, WSB(WS_WMO), 512, M, 1024, 512); }
    if (G == 256) grp_barrier(bar); else xcd_barrier(bar);
    { pg8::EpiSwiGLURS E; E.H = WSB(WS_H); E.ssq = (const float*)ws_at(P_WS, WS_SSQ2); E.ldh = DFF; E.inv_ncols = 1.0f / 1024.0f; E.eps = EPS; E.pad = 0; GEMM_PHASE(pg8::EpiSwiGLURS, E, WSB(WS_XN), 1024, WSB(WS_WGU), 1024, M, 2 * DFF, 1024); }
    if (G == 256) grp_barrier(bar); else xcd_barrier(bar);
    { pg8::EpiResB16 E; E.baseb = WSB(WS_XN); E.out = P_OUT; E.ldc = 1024; E.pad = 0; GEMM_PHASE(pg8::EpiResB16, E, WSB(WS_H), DFF, WSB(WS_WDN), DFF, M, 1024, DFF); }
}

extern "C" void kernel_launch(void* const* d_in, const int* in_sizes, int n_in, void* d_out, int out_size, void* d_ws, size_t ws_size, hipStream_t stream) {
    static int grid = 0;
    if (grid == 0) {
        if (n_in != 27 || in_sizes[0] != M * DM || out_size != M * DM || ws_size < WS_END) { fprintf(stderr, "kernel_launch: unexpected shapes (n_in %d, in0 %d, out %d, ws %zu)\n", n_in, n_in > 0 ? in_sizes[0] : -1, out_size, ws_size); grid = -1; return; }
        int dev = 0, cus = 0, per_cu = 0;
        if (hipGetDevice(&dev) != hipSuccess || hipDeviceGetAttribute(&cus, hipDeviceAttributeMultiprocessorCount, dev) != hipSuccess) { fprintf(stderr, "kernel_launch: device query failed\n"); grid = -1; return; }
        if (hipFuncSetAttribute((const void*)mega_fwd, hipFuncAttributeMaxDynamicSharedMemorySize, LDS_BYTES) != hipSuccess) { fprintf(stderr, "kernel_launch: hipFuncSetAttribute failed\n"); grid = -1; return; }
        if (hipOccupancyMaxActiveBlocksPerMultiprocessor(&per_cu, (const void*)mega_fwd, NTHREADS, LDS_BYTES) != hipSuccess || per_cu < 1) { fprintf(stderr, "kernel_launch: occupancy query reports %d blocks per CU\n", per_cu); }
        (void)hipGetLastError();
        grid = cus;
    }
    if (grid < 0) return;
    (void)hipMemsetAsync((char*)d_ws + WS_CTL, 0, CTL_ZERO_BYTES, stream);
    Params p{};
    for (int i = 0; i < 27; ++i) p.in[i] = (const float*)d_in[i];
    p.out = (float*)d_out; p.ws = (unsigned char*)d_ws;
    hipLaunchKernelGGL(mega_fwd, dim3(grid), dim3(NTHREADS), LDS_BYTES, stream, p);
}
```
